# Optimizing an MI355X kernel written in HIP

```python
import math
import jax
import jax.numpy as jnp
from jax import lax
import numpy as np

D_MODEL = 1024
BATCH = 8
SEQ = 4096
DEPTH = 1

HEAD_DIM = 64
NSA_HEADS = 8
NSA_KV_GROUPS = 2
NSA_GROUP = NSA_HEADS // NSA_KV_GROUPS
NSA_WIDTH = NSA_HEADS * HEAD_DIM
NSA_KV_WIDTH = NSA_KV_GROUPS * HEAD_DIM
CMP_BLOCK = 32
CMP_STRIDE = 16
CMP_SPAN = CMP_BLOCK // CMP_STRIDE
CMP_HIDDEN = 256
SLC_BLOCK = 64
SLC_RATIO = SLC_BLOCK // CMP_STRIDE
SLC_TOPK = 16
OVERLAP_W = (1, 2, 2, 2, 1)
WINDOW = 512
WIN_QBLOCK = 128
REL_BUCKETS = 32
REL_MAX_DIST = 128
RWKV_HEADS = 8
RWKV_WIDTH = RWKV_HEADS * HEAD_DIM
LORA_W = 64
LORA_A = 64
LORA_G = 128
GN_EPS = 64e-5
D_FF = 2816
CONV_WIDTH = 3
RMS_EPS = 1e-6
NEG_INF = -1e30
FORCE = 1e9

RWKV_SIZES = (RWKV_WIDTH, RWKV_WIDTH, RWKV_WIDTH, LORA_W, LORA_A, LORA_G)
RWKV_IN_WIDTH = sum(RWKV_SIZES)
RWKV_SPLITS = tuple(np.cumsum(RWKV_SIZES)[:-1].tolist())
IN_SIZES = (NSA_WIDTH, NSA_KV_WIDTH, NSA_KV_WIDTH, NSA_KV_WIDTH, NSA_KV_WIDTH, NSA_KV_WIDTH, NSA_KV_WIDTH,
            NSA_HEADS * 3, RWKV_IN_WIDTH, D_MODEL, D_MODEL)
IN_WIDTH = sum(IN_SIZES)
IN_SPLITS = tuple(np.cumsum(IN_SIZES)[:-1].tolist())

kernel_name = 'hybrid_nsa_rwkv7_convffn'


def rmsnorm(x, g):
    xf = x.astype(jnp.float32)
    y = xf * lax.rsqrt(jnp.mean(xf * xf, axis=-1, keepdims=True) + RMS_EPS)
    return (y * g.astype(jnp.float32)).astype(x.dtype)


def t5_bucket(dist):
    n = jnp.maximum(dist, 0)
    max_exact = REL_BUCKETS // 2
    ratio = jnp.log(jnp.maximum(n, 1).astype(jnp.float32) / max_exact) / math.log(REL_MAX_DIST / max_exact)
    large = jnp.minimum(max_exact + (ratio * (REL_BUCKETS - max_exact)).astype(jnp.int32), REL_BUCKETS - 1)
    return jnp.where(n < max_exact, n, large)


def masked_softmax(s, mask, axis):
    s = jnp.where(mask, s.astype(jnp.float32), NEG_INF)
    e = jnp.exp(s - jnp.max(s, axis=axis, keepdims=True)) * mask
    return e / jnp.maximum(jnp.sum(e, axis=axis, keepdims=True), 1e-30)


def compress_blocks(kv, pe, w1, w2):
    b, s, g, dh = kv.shape
    chunks = kv.reshape(b, s // CMP_STRIDE, CMP_STRIDE, g, dh)
    n_cmp = s // CMP_STRIDE - CMP_SPAN + 1
    blocks = jnp.concatenate([chunks[:, i:i + n_cmp] for i in range(CMP_SPAN)], axis=2)
    blocks = blocks + pe[None, None, :, None, :]
    flat = blocks.transpose(0, 1, 3, 2, 4).reshape(b, n_cmp, g, CMP_BLOCK * dh)
    return jax.nn.gelu(flat @ w1) @ w2


def nsa_mixer(q, k_c, v_c, k_s, v_s, k_w, v_w, gate, rel_bias, q_norm_g, k_norm_g,
              cmp_pe_k, cmp_w1_k, cmp_w2_k, cmp_pe_v, cmp_w1_v, cmp_w2_v):
    b, s, _ = q.shape
    G, R, dh = NSA_KV_GROUPS, NSA_GROUP, HEAD_DIM
    q = rmsnorm(q.reshape(b, s, G, R, dh), q_norm_g) * (dh ** -0.5)
    k_c, v_c, k_s, v_s, k_w, v_w = [t.reshape(b, s, G, dh) for t in (k_c, v_c, k_s, v_s, k_w, v_w)]
    t_pos = jnp.arange(s)
    bias_tab = rel_bias.reshape(REL_BUCKETS, G, R)

    kc = rmsnorm(compress_blocks(k_c, cmp_pe_k, cmp_w1_k, cmp_w2_k), k_norm_g)
    vc = compress_blocks(v_c, cmp_pe_v, cmp_w1_v, cmp_w2_v)
    n_cmp = kc.shape[1]
    blk_end = jnp.arange(n_cmp) * CMP_STRIDE + CMP_BLOCK - 1
    dist_c = t_pos[:, None] - blk_end[None, :]
    bias_c = bias_tab[t5_bucket(dist_c)].transpose(2, 3, 0, 1)
    s_c = jnp.einsum('bsgrd,bcgd->bgrsc', q, kc).astype(jnp.float32) + bias_c
    p_c = masked_softmax(s_c, dist_c >= 0, axis=-1)
    o_cmp = jnp.einsum('bgrsc,bcgd->bsgrd', p_c, vc)

    n_slc = s // SLC_BLOCK
    imp_c = jnp.sum(p_c, axis=2)
    imp_pad = jnp.pad(imp_c, ((0, 0), (0, 0), (0, 0), (CMP_SPAN - 1, CMP_SPAN)))
    imp = OVERLAP_W[0] * imp_pad[..., 0:SLC_RATIO * n_slc:SLC_RATIO]
    for o in range(1, SLC_RATIO + CMP_SPAN - 1):
        imp = imp + OVERLAP_W[o] * imp_pad[..., o:o + SLC_RATIO * n_slc:SLC_RATIO]
    blk = jnp.arange(n_slc)[None, :]
    cur = (t_pos // SLC_BLOCK)[:, None]
    forced = (blk == 0) | (blk == cur) | (blk == cur - 1)
    score = jnp.where(forced, FORCE, jnp.where(blk <= cur, imp, -FORCE))
    n_sel = min(SLC_TOPK, n_slc)
    _, idx = lax.top_k(score, n_sel)
    sel_valid = idx <= cur

    nq = s // SLC_BLOCK
    k_blocks = rmsnorm(k_s, k_norm_g).reshape(b, n_slc, SLC_BLOCK, G, dh).transpose(0, 3, 1, 2, 4)
    v_blocks = v_s.reshape(b, n_slc, SLC_BLOCK, G, dh).transpose(0, 3, 1, 2, 4)
    gather = jax.vmap(jax.vmap(lambda blocks, ix: blocks[ix]))
    gi = jnp.arange(G).reshape(1, G, 1, 1, 1, 1)
    ri = jnp.arange(R).reshape(1, 1, R, 1, 1, 1)

    def slc_block(args):
        q_b, idx_b, val_b, t_b = args
        k_sel = gather(k_blocks, idx_b)
        v_sel = gather(v_blocks, idx_b)
        kpos = idx_b[..., None] * SLC_BLOCK + jnp.arange(SLC_BLOCK)
        dist = t_b[:, None, None] - kpos
        mask = (val_b[..., None] & (dist >= 0))[:, :, None]
        bias = bias_tab[t5_bucket(dist)[:, :, None], gi, ri]
        sc = jnp.einsum('bcgrd,bgcnld->bgrcnl', q_b, k_sel).astype(jnp.float32) + bias
        p = masked_softmax(sc, mask, axis=(-2, -1))
        return jnp.einsum('bgrcnl,bgcnld->bcgrd', p, v_sel)

    q_ch = jnp.moveaxis(q.reshape(b, nq, SLC_BLOCK, G, R, dh), 1, 0)
    idx_ch = jnp.moveaxis(idx.reshape(b, G, nq, SLC_BLOCK, n_sel), 2, 0)
    val_ch = jnp.moveaxis(sel_valid.reshape(b, G, nq, SLC_BLOCK, n_sel), 2, 0)
    t_ch = t_pos.reshape(nq, SLC_BLOCK)
    o_slc = jnp.moveaxis(lax.map(slc_block, (q_ch, idx_ch, val_ch, t_ch)), 0, 1).reshape(b, s, G, R, dh)

    nw = s // WIN_QBLOCK
    k_pad = jnp.pad(rmsnorm(k_w, k_norm_g), ((0, 0), (WINDOW, 0), (0, 0), (0, 0)))
    v_pad = jnp.pad(v_w, ((0, 0), (WINDOW, 0), (0, 0), (0, 0)))

    def win_block(args):
        q_b, i = args
        start = i * WIN_QBLOCK
        kw = lax.dynamic_slice_in_dim(k_pad, start, WIN_QBLOCK + WINDOW, axis=1)
        vw = lax.dynamic_slice_in_dim(v_pad, start, WIN_QBLOCK + WINDOW, axis=1)
        t_b = start + jnp.arange(WIN_QBLOCK)
        s_b = start - WINDOW + jnp.arange(WIN_QBLOCK + WINDOW)
        dist = t_b[:, None] - s_b[None, :]
        mask = (dist >= 0) & (dist < WINDOW) & (s_b[None, :] >= 0)
        bias = bias_tab[t5_bucket(dist)].transpose(2, 3, 0, 1)
        sc = jnp.einsum('bqgrd,bkgd->bgrqk', q_b, kw).astype(jnp.float32) + bias
        p = masked_softmax(sc, mask, axis=-1)
        return jnp.einsum('bgrqk,bkgd->bqgrd', p, vw)

    q_wch = jnp.moveaxis(q.reshape(b, nw, WIN_QBLOCK, G, R, dh), 1, 0)
    o_win = jnp.moveaxis(lax.map(win_block, (q_wch, jnp.arange(nw))), 0, 1).reshape(b, s, G, R, dh)

    gt = jax.nn.sigmoid(gate.reshape(b, s, G, R, 3).astype(jnp.float32))
    o = gt[..., 0:1] * o_cmp + gt[..., 1:2] * o_slc + gt[..., 2:3] * o_win
    return o.reshape(b, s, NSA_WIDTH)


def rwkv7_mixer(p_in, mu, w0, w2, a0, a2, g2, k_k, k_a, r_k, ln_g, ln_b):
    b, s, _ = p_in.shape
    H, N = RWKV_HEADS, HEAD_DIM
    shifted = jnp.pad(p_in, ((0, 0), (1, 0), (0, 0)))[:, :-1]
    xl = p_in + (shifted - p_in) * mu
    r, k, v, xw, xa, xg = jnp.split(xl, RWKV_SPLITS, axis=-1)
    w = -jax.nn.softplus(-(w0 + jnp.tanh(xw) @ w2)) - 0.5
    decay = jnp.exp(-jnp.exp(w.astype(jnp.float32)))
    a = jax.nn.sigmoid(a0 + xa @ a2)
    g = jax.nn.sigmoid(xg) @ g2
    heads = lambda t: t.reshape(b, s, H, N).astype(jnp.float32)
    r, k, v, a, decay = heads(r), heads(k), heads(v), heads(a), heads(decay)
    kk = k * k_k.reshape(H, N).astype(jnp.float32)
    kk = kk / jnp.maximum(jnp.sqrt(jnp.sum(kk * kk, axis=-1, keepdims=True)), 1e-12)
    k = k * (1.0 + (a - 1.0) * k_a.reshape(H, N).astype(jnp.float32))
    xs = tuple(jnp.moveaxis(t, 1, 0) for t in (r, decay, k, v, -kk, kk * a))

    def step(state, inp):
        r_t, w_t, k_t, v_t, a_t, b_t = inp
        sa = jnp.einsum('bhij,bhj->bhi', state, a_t)
        state = state * w_t[:, :, None, :] + sa[..., None] * b_t[:, :, None, :] + v_t[..., None] * k_t[:, :, None, :]
        return state, jnp.einsum('bhij,bhj->bhi', state, r_t)

    state0 = jnp.zeros((b, H, N, N), jnp.float32)
    _, y = lax.scan(step, state0, xs)
    y = jnp.moveaxis(y, 0, 1)
    mean = jnp.mean(y, axis=-1, keepdims=True)
    var = jnp.mean(jnp.square(y - mean), axis=-1, keepdims=True)
    y = (y - mean) * lax.rsqrt(var + GN_EPS) * ln_g.reshape(H, N) + ln_b.reshape(H, N)
    y = y + jnp.sum(r * k * r_k, axis=-1, keepdims=True) * v
    return y.reshape(b, s, RWKV_WIDTH) * g


def conv_ffn(h, w_up, conv_w, conv_b, w_down):
    u = h @ w_up
    s = u.shape[1]
    up = jnp.pad(u, ((0, 0), (CONV_WIDTH - 1, 0), (0, 0)))
    c = conv_b + conv_w[0] * up[:, 0:s]
    for j in range(1, CONV_WIDTH):
        c = c + conv_w[j] * up[:, j:j + s]
    val, gate = jnp.split(c, 2, axis=-1)
    return (jax.nn.silu(gate) * val) @ w_down


def setup_inputs(seed: int = 0) -> dict:
    key = jax.random.key(seed)
    ks = iter(jax.random.split(key, 40))
    L, D = DEPTH, D_MODEL

    def nrm(shape, scale):
        return scale * jax.random.normal(next(ks), shape, jnp.float32)

    def unif(shape, lo, hi):
        return jax.random.uniform(next(ks), shape, jnp.float32, lo, hi)

    return {
        'x': nrm((BATCH, SEQ, D), 1.0),
        'attn_norm_g': 1.0 + nrm((L, D), 0.1),
        'w_in': nrm((L, D, IN_WIDTH), D ** -0.5),
        'rel_bias': nrm((REL_BUCKETS, NSA_HEADS), 0.5),
        'q_norm_g': 1.0 + nrm((L, HEAD_DIM), 0.1),
        'k_norm_g': 1.0 + nrm((L, HEAD_DIM), 0.1),
        'cmp_pe_k': nrm((L, CMP_BLOCK, HEAD_DIM), 0.1),
        'cmp_w1_k': nrm((L, CMP_BLOCK * HEAD_DIM, CMP_HIDDEN), (CMP_BLOCK * HEAD_DIM) ** -0.5),
        'cmp_w2_k': nrm((L, CMP_HIDDEN, HEAD_DIM), CMP_HIDDEN ** -0.5),
        'cmp_pe_v': nrm((L, CMP_BLOCK, HEAD_DIM), 0.1),
        'cmp_w1_v': nrm((L, CMP_BLOCK * HEAD_DIM, CMP_HIDDEN), (CMP_BLOCK * HEAD_DIM) ** -0.5),
        'cmp_w2_v': nrm((L, CMP_HIDDEN, HEAD_DIM), CMP_HIDDEN ** -0.5),
        'rwkv_mu': unif((L, RWKV_IN_WIDTH), 0.0, 1.0),
        'rwkv_w0': unif((L, RWKV_WIDTH), -6.0, -1.0),
        'rwkv_w2': nrm((L, LORA_W, RWKV_WIDTH), 0.5 * LORA_W ** -0.5),
        'rwkv_a0': nrm((L, RWKV_WIDTH), 0.1),
        'rwkv_a2': nrm((L, LORA_A, RWKV_WIDTH), 0.5 * LORA_A ** -0.5),
        'rwkv_g2': nrm((L, LORA_G, RWKV_WIDTH), LORA_G ** -0.5),
        'rwkv_k_k': 0.85 + nrm((L, RWKV_WIDTH), 0.05),
        'rwkv_k_a': 1.0 + nrm((L, RWKV_WIDTH), 0.05),
        'rwkv_r_k': nrm((L, RWKV_HEADS, HEAD_DIM), 0.1),
        'rwkv_ln_g': 1.0 + nrm((L, RWKV_WIDTH), 0.1),
        'rwkv_ln_b': nrm((L, RWKV_WIDTH), 0.01),
        'w_proj_a': nrm((L, NSA_WIDTH, D), NSA_WIDTH ** -0.5),
        'w_proj_b': nrm((L, RWKV_WIDTH, D), RWKV_WIDTH ** -0.5),
        'w_out': nrm((L, D, D), D ** -0.5),
        'ffn_norm_g': 1.0 + nrm((L, D), 0.1),
        'w_up': nrm((L, D, 2 * D_FF), D ** -0.5),
        'conv_w': nrm((L, CONV_WIDTH, 2 * D_FF), CONV_WIDTH ** -0.5),
        'conv_b': nrm((L, 2 * D_FF), 0.01),
        'w_down': nrm((L, D_FF, D), D_FF ** -0.5),
    }


def reference(x, attn_norm_g, w_in, rel_bias, q_norm_g, k_norm_g, cmp_pe_k, cmp_w1_k, cmp_w2_k,
              cmp_pe_v, cmp_w1_v, cmp_w2_v, rwkv_mu, rwkv_w0, rwkv_w2, rwkv_a0, rwkv_a2, rwkv_g2,
              rwkv_k_k, rwkv_k_a, rwkv_r_k, rwkv_ln_g, rwkv_ln_b, w_proj_a, w_proj_b, w_out,
              ffn_norm_g, w_up, conv_w, conv_b, w_down):
    for l in range(DEPTH):
        h = rmsnorm(x, attn_norm_g[l])
        proj = h @ w_in[l]
        q, k_c, v_c, k_s, v_s, k_w, v_w, nsa_gate, rwkv_in, gate_a, gate_b = jnp.split(proj, IN_SPLITS, axis=-1)
        o_a = nsa_mixer(q, k_c, v_c, k_s, v_s, k_w, v_w, nsa_gate, rel_bias, q_norm_g[l], k_norm_g[l],
                        cmp_pe_k[l], cmp_w1_k[l], cmp_w2_k[l], cmp_pe_v[l], cmp_w1_v[l], cmp_w2_v[l])
        o_b = rwkv7_mixer(rwkv_in, rwkv_mu[l], rwkv_w0[l], rwkv_w2[l], rwkv_a0[l], rwkv_a2[l], rwkv_g2[l],
                          rwkv_k_k[l], rwkv_k_a[l], rwkv_r_k[l], rwkv_ln_g[l], rwkv_ln_b[l])
        merged = jax.nn.sigmoid(gate_a) * (o_a @ w_proj_a[l]) + jax.nn.sigmoid(gate_b) * (o_b @ w_proj_b[l])
        x = x + (merged @ w_out[l]).astype(x.dtype)
        h2 = rmsnorm(x, ffn_norm_g[l])
        x = x + conv_ffn(h2, w_up[l], conv_w[l], conv_b[l], w_down[l]).astype(x.dtype)
    return x
```

```cpp
#include <hip/hip_runtime.h>
#include <cstdio>
#include <cstdint>

#define LAS __attribute__((address_space(3)))
#define GAS __attribute__((address_space(1)))
typedef unsigned short bf16_t;
typedef short bf16x8 __attribute__((ext_vector_type(8)));
typedef short s16x4 __attribute__((ext_vector_type(4)));
typedef float f32x2 __attribute__((ext_vector_type(2)));
typedef float f32x4 __attribute__((ext_vector_type(4)));
typedef float f32x16 __attribute__((ext_vector_type(16)));
typedef unsigned u32x2 __attribute__((ext_vector_type(2)));
typedef unsigned u32x4 __attribute__((ext_vector_type(4)));

constexpr int NB = 8, SEQ = 4096, DM = 1024, NT = NB * SEQ;
constexpr int NPROJ = 5120;
constexpr int QW = 512, KVW = 768, RWW = 1792, GTW = 24;
constexpr int DFF = 2816, DFF2 = 5632;
constexpr int NCMP = 255, CMPROWS = 4096;
constexpr float RMS_EPS = 1e-6f, GN_EPS = 64e-5f;
constexpr float LOG2E = 1.4426950408889634f;

constexpr size_t MiB = 1u << 20;
constexpr size_t WS_CTL = 0;
constexpr size_t WS_WIN = 1 * MiB;
constexpr size_t WS_WPA = 12 * MiB;
constexpr size_t WS_WPB = 13 * MiB;
constexpr size_t WS_WOUT = 14 * MiB;
constexpr size_t WS_WUP = 16 * MiB;
constexpr size_t WS_WDN = 27 * MiB;
constexpr size_t WS_WC1K = 33 * MiB;
constexpr size_t WS_WC1V = 34 * MiB;
constexpr size_t WS_MISC = 35 * MiB;
constexpr size_t WS_KC = WS_MISC, WS_VC = WS_MISC + 1 * MiB, WS_SEL = WS_MISC + 2 * MiB;
constexpr size_t WS_PS = WS_MISC;
constexpr size_t WS_WC2T = 38 * MiB + 262144;
constexpr size_t WS_KCB = 38 * MiB + 524288, WS_VCB = 39 * MiB;
constexpr size_t WS_H = 40 * MiB;
constexpr size_t WS_FK = 136 * MiB, WS_FV = 152 * MiB, WS_HK = 168 * MiB, WS_HV = 170 * MiB;
constexpr size_t WS_Q = 104 * MiB;
constexpr size_t WS_KV = 136 * MiB;
constexpr size_t WS_RW = 184 * MiB;
constexpr size_t WS_ACT = WS_Q;
constexpr size_t WS_MRG = WS_RW + 48 * MiB;
constexpr size_t WS_GA = 296 * MiB;
constexpr size_t WS_GB = 360 * MiB;
constexpr size_t WS_U4 = WS_GA;
constexpr size_t WS_GT = 424 * MiB;
constexpr size_t WS_KSN = 428 * MiB;
constexpr size_t WS_KWN = 436 * MiB;
constexpr size_t WS_OA = 444 * MiB;
constexpr size_t WS_OB = 476 * MiB;
constexpr size_t WS_VSN = WS_OB, WS_VWN = WS_OB + 8 * MiB;
constexpr size_t WS_OCMP = WS_OB;
constexpr size_t WS_END = 508 * MiB;

constexpr int LDS_BYTES = 147456 + 256;

__device__ __forceinline__ float bf2f(bf16_t v) { return __uint_as_float((unsigned)v << 16); }
__device__ __forceinline__ unsigned f2bf(float f) { unsigned u = __float_as_uint(f); return (u + 0x7fffu + ((u >> 16) & 1u)) >> 16; }
__device__ __forceinline__ unsigned pk2(float lo, float hi) { return f2bf(lo) | (f2bf(hi) << 16); }
__device__ __forceinline__ float bflo(unsigned w) { return __uint_as_float(w << 16); }
__device__ __forceinline__ float bfhi(unsigned w) { return __uint_as_float(w & 0xffff0000u); }
__device__ __forceinline__ float wave_sum(float v) {
#pragma unroll
    for (int o = 1; o < 64; o <<= 1) v += __shfl_xor(v, o);
    return v;
}
__device__ __forceinline__ float wave_max(float v) {
#pragma unroll
    for (int o = 1; o < 64; o <<= 1) v = fmaxf(v, __shfl_xor(v, o));
    return v;
}
__device__ __forceinline__ float sigmoidf_(float x) { return __builtin_amdgcn_rcpf(1.0f + __builtin_amdgcn_exp2f(-1.4426950408889634f * x)); }
__device__ __forceinline__ float gelu_tanh(float x) { const float z = 0.7978845608028654f * (x + 0.044715f * x * x * x); const float e = __builtin_amdgcn_exp2f(2.8853900817779268f * z); return x * (1.0f - __builtin_amdgcn_rcpf(e + 1.0f)); }
__device__ __forceinline__ int t5_bucket(int n) {
    if (n < 16) return n < 0 ? 0 : n;
    return 16 + (n >= 19) + (n >= 21) + (n >= 24) + (n >= 27) + (n >= 31) + (n >= 35) + (n >= 40) + (n >= 46) + (n >= 52) + (n >= 59) + (n >= 67) + (n >= 77) + (n >= 87) + (n >= 99) + (n >= 113);
}
namespace pg8 {
#define PG8_LAS __attribute__((address_space(3)))
typedef unsigned short bf16_t;
typedef short bf16x8 __attribute__((ext_vector_type(8)));
typedef float f32x4 __attribute__((ext_vector_type(4)));
typedef unsigned u32x4 __attribute__((ext_vector_type(4)));
constexpr int BM = 256, BK = 64, HALF = 128, HTB = HALF * BK * 2  , STAGE_BYTES = 8 * HTB, NXCD = 8, WGM = 8;

__host__ __device__ __forceinline__ int lds_byte(int r, int c) { const int st = (r >> 4) * 2 + (c >> 5), rr = r & 15, cc = c & 31, ob = rr * 64 + cc * 2; return st * 1024 + (ob ^ (((ob >> 9) & 1) << 5)); }
__host__ __device__ __forceinline__ void stage_rc(int b, int& R, int& C) { const int st = b / 1024, sb = b % 1024, swz = sb ^ (((sb >> 9) & 1) << 5); R = (st >> 1) * 16 + swz / 64; C = (st & 1) * 32 + (swz % 64) / 2; }
__host__ __device__ __forceinline__ int perm32(int rho) { const int n = rho >> 4, i = rho & 15; return 8 * (i >> 2) + 4 * n + (i & 3); }

struct Unit { int pm, pn; };
struct Gemm { const bf16_t* A; const bf16_t* Bt; int M, N, K; int ld; int ablk; };

struct StaticOrder {
    int nM, nN, nwg, G, c;
    __host__ __device__ __forceinline__ void init(int M, int N, int G_, int c_) { nM = M / BM; nN = N / BM; nwg = nM * nN; G = G_; c = c_; }
    __host__ __device__ __forceinline__ bool next(int i, Unit& u) const {
        const long L = (long)i * G + c; if (L >= nwg) return false;
        int wgid = (int)L; { const int q = nwg / NXCD, r = nwg % NXCD, xcd = wgid % NXCD, off = wgid / NXCD; wgid = (xcd < r ? xcd * (q + 1) : r * (q + 1) + (xcd - r) * q) + off; }
        const int nig = WGM * nN, gid = wgid / nig, fm = gid * WGM, gsz = (nM - fm) < WGM ? (nM - fm) : WGM;
        u.pm = fm + ((wgid % nig) % gsz); u.pn = (wgid % nig) / gsz; return true;
    }
    __device__ __forceinline__ void a_ready(const Unit&) const {}
    __device__ __forceinline__ void done(const Unit&) const {}
};

struct NormOrder : StaticOrder {
    const float* PS; PG8_LAS float* tab; mutable int last, tag0, tag1;
    __device__ __forceinline__ void a_ready(const Unit& u) const {
        if ((last ? tag1 : tag0) == u.pm) return;
        last ^= 1; if (last) tag1 = u.pm; else tag0 = u.pm;
        const int tid = threadIdx.x;
        if (tid < 256) { const float* pp = PS + (size_t)(u.pm * BM + tid) * 16; const f32x4 a0 = *(const f32x4*)pp, a1 = *(const f32x4*)(pp + 4), a2 = *(const f32x4*)(pp + 8), a3 = *(const f32x4*)(pp + 12);
            tab[last * 256 + tid] = rsqrtf((((a0[0] + a0[1]) + (a0[2] + a0[3])) + ((a1[0] + a1[1]) + (a1[2] + a1[3])) + ((a2[0] + a2[1]) + (a2[2] + a2[3])) + ((a3[0] + a3[1]) + (a3[2] + a3[3]))) * (1.f / 1024.f) + 1e-6f); }
        if (tid == 0) ((PG8_LAS int*)(tab + 512))[last] = u.pm;
    }
};

__device__ __forceinline__ unsigned cvt_pk_bf16(float lo, float hi) { typedef float f2_ __attribute__((ext_vector_type(2))); typedef __bf16 b2_ __attribute__((ext_vector_type(2))); const f2_ v = {lo, hi}; const b2_ b = __builtin_convertvector(v, b2_); return __builtin_bit_cast(unsigned, b); }
typedef float f32x2 __attribute__((ext_vector_type(2)));
__device__ __forceinline__ float sigm(float x) { return __builtin_amdgcn_rcpf(1.0f + __builtin_amdgcn_exp2f(-1.4426950408889634f * x)); }
__device__ __forceinline__ f32x4 sigm4(f32x4 v) { return (f32x4){sigm(v[0]), sigm(v[1]), sigm(v[2]), sigm(v[3])}; }
__device__ __forceinline__ u32x4 pack8(f32x4 v0, f32x4 v1) { u32x4 w; w.x = cvt_pk_bf16(v0[0], v0[1]); w.y = cvt_pk_bf16(v0[2], v0[3]); w.z = cvt_pk_bf16(v1[0], v1[1]); w.w = cvt_pk_bf16(v1[2], v1[3]); return w; }
__device__ __forceinline__ float blo(unsigned w) { return __uint_as_float(w << 16); }
__device__ __forceinline__ float bhi(unsigned w) { return __uint_as_float(w & 0xffff0000u); }

struct EpiProj {
    static constexpr bool PERM = true, AFTER_DRAIN = false;
    unsigned char* ws; const float *qg, *kg; const PG8_LAS float* pel;
    __device__ __forceinline__ void operator()(const f32x4 (&acc)[2][2][4][2], const Unit& u, int wr, int wc, int fr, int fq) const {
        const int pn = u.pn; const int row0 = u.pm * BM + wr * 128 + fr;
        bf16_t* const Q = (bf16_t*)(ws + WS_Q); bf16_t* const FK = (bf16_t*)(ws + WS_FK); bf16_t* const FV = (bf16_t*)(ws + WS_FV); bf16_t* const KSN = (bf16_t*)(ws + WS_KSN); bf16_t* const KWN = (bf16_t*)(ws + WS_KWN);
        bf16_t* const VSN = (bf16_t*)(ws + WS_VSN); bf16_t* const VWN = (bf16_t*)(ws + WS_VWN); bf16_t* const RW = (bf16_t*)(ws + WS_RW); bf16_t* const GA = (bf16_t*)(ws + WS_GA); bf16_t* const GB = (bf16_t*)(ws + WS_GB); float* const GT = (float*)(ws + WS_GT);
        if (pn < 5) {
            const int d0 = 8 * fq;
            if (pn < 2 || (pn >= 3 && wc < 2)) {
                const float* gp = pn < 2 ? qg : kg; const float sc = pn < 2 ? 0.125f * 1.4426950408889634f : 1.0f;
                f32x4 gv[2][2];
#pragma unroll
                for (int bj = 0; bj < 2; ++bj)
#pragma unroll
                    for (int n = 0; n < 2; ++n) gv[bj][n] = *(const f32x4*)(gp + 32 * bj + d0 + 4 * n) * sc;
                bf16_t* base = pn < 2 ? Q + (4 * pn + wc) * 64 : (pn == 3 ? KSN : KWN) + wc * 64; const int ldc = pn < 2 ? 512 : 128;
#pragma unroll
                for (int ai = 0; ai < 2; ++ai)
#pragma unroll
                    for (int m = 0; m < 4; ++m) {
                        float ss = 0.f;
#pragma unroll
                        for (int bj = 0; bj < 2; ++bj)
#pragma unroll
                            for (int n = 0; n < 2; ++n) { const f32x4 v = acc[ai][bj][m][n]; ss += (v[0] * v[0] + v[1] * v[1]) + (v[2] * v[2] + v[3] * v[3]); }
                        ss += __shfl_xor(ss, 16); ss += __shfl_xor(ss, 32);
                        const float rs = rsqrtf(ss * (1.f / 64.f) + 1e-6f);
                        bf16_t* rowp = base + (size_t)(row0 + ai * 64 + m * 16) * ldc + d0;
#pragma unroll
                        for (int bj = 0; bj < 2; ++bj) *(u32x4*)(rowp + 32 * bj) = pack8(acc[ai][bj][m][0] * rs * gv[bj][0], acc[ai][bj][m][1] * rs * gv[bj][1]);
                    }
            } else if (pn >= 3) {
                bf16_t* base = (pn == 3 ? VSN : VWN) + (wc - 2) * 64;
#pragma unroll
                for (int ai = 0; ai < 2; ++ai)
#pragma unroll
                    for (int m = 0; m < 4; ++m) { bf16_t* rowp = base + (size_t)(row0 + ai * 64 + m * 16) * 128 + d0;
#pragma unroll
                        for (int bj = 0; bj < 2; ++bj) *(u32x4*)(rowp + 32 * bj) = pack8(acc[ai][bj][m][0], acc[ai][bj][m][1]); }
            } else {
                bf16_t* F = wc < 2 ? FK : FV; const PG8_LAS float* pe = pel + (wc < 2 ? 0 : 2048); const int g = wc & 1;
#pragma unroll
                for (int ai = 0; ai < 2; ++ai)
#pragma unroll
                    for (int m = 0; m < 4; ++m) { const int row = row0 + ai * 64 + m * 16; const int b = row >> 12, t = row & 4095, cb = t >> 4, l0 = t & 15;
#pragma unroll
                        for (int w = 0; w < 2; ++w) { const int cc = cb - w, l = l0 + 16 * w;
                            if (cc >= 0 && cc < 255) { bf16_t* rowp = F + ((size_t)((b * 255 + cc) * 2 + g)) * 2048 + l * 64 + d0; const PG8_LAS float* pp = pe + l * 64 + d0;
#pragma unroll
                                for (int bj = 0; bj < 2; ++bj) *(u32x4*)(rowp + 32 * bj) = pack8(acc[ai][bj][m][0] + *(const PG8_LAS f32x4*)(pp + 32 * bj), acc[ai][bj][m][1] + *(const PG8_LAS f32x4*)(pp + 32 * bj + 4)); } } }
            }
        } else if (pn < 20) {
            bf16_t* base; int ldc, colt; bool sg = false;
            if (pn < 12) { base = RW; ldc = 1792; colt = (pn - 5) * 256; }
            else if (pn < 16) { base = GA; ldc = 1024; colt = (pn - 12) * 256; sg = true; }
            else { base = GB; ldc = 1024; colt = (pn - 16) * 256; sg = true; }
            const int col0 = colt + wc * 32 + 8 * fq;
#pragma unroll
            for (int ai = 0; ai < 2; ++ai)
#pragma unroll
                for (int m = 0; m < 4; ++m) { bf16_t* rowp = base + (size_t)(row0 + ai * 64 + m * 16) * ldc + col0;
#pragma unroll
                    for (int bj = 0; bj < 2; ++bj) { f32x4 v0 = acc[ai][bj][m][0], v1 = acc[ai][bj][m][1];
                        if (sg) { v0 = sigm4(v0); v1 = sigm4(v1); }
                        *(u32x4*)(rowp + bj * HALF) = pack8(v0, v1); } }
        } else {
            if (wc == 0 && fq < 3) {
#pragma unroll
                for (int ai = 0; ai < 2; ++ai)
#pragma unroll
                    for (int m = 0; m < 4; ++m) { float* rowp = GT + (size_t)(row0 + ai * 64 + m * 16) * 24 + 8 * fq;
#pragma unroll
                        for (int n = 0; n < 2; ++n) *(f32x4*)(rowp + 4 * n) = sigm4(acc[ai][0][m][n]); }
            }
        }
    }
};
template <int ACT> struct EpiBf16 {
    static constexpr bool PERM = true, AFTER_DRAIN = false;
    bf16_t* O; int ldc;
    __device__ __forceinline__ void operator()(const f32x4 (&acc)[2][2][4][2], const Unit& u, int wr, int wc, int fr, int fq) const {
        const int row0 = u.pm * BM + wr * 128 + fr, col0 = u.pn * BM + wc * 32 + 8 * fq;
#pragma unroll
        for (int ai = 0; ai < 2; ++ai)
#pragma unroll
            for (int m = 0; m < 4; ++m) { bf16_t* rowp = O + (size_t)(row0 + ai * 64 + m * 16) * ldc + col0;
#pragma unroll
                for (int bj = 0; bj < 2; ++bj) { f32x4 v0 = acc[ai][bj][m][0], v1 = acc[ai][bj][m][1];
                    if (ACT == 1) { v0 = (f32x4){gelu_tanh(v0[0]), gelu_tanh(v0[1]), gelu_tanh(v0[2]), gelu_tanh(v0[3])}; v1 = (f32x4){gelu_tanh(v1[0]), gelu_tanh(v1[1]), gelu_tanh(v1[2]), gelu_tanh(v1[3])}; }
                    *(u32x4*)(rowp + bj * HALF) = pack8(v0, v1); } }
    }
};
struct EpiPartial {
    static constexpr bool PERM = true, AFTER_DRAIN = false;
    unsigned char* wsb; int isv;
    __device__ __forceinline__ void operator()(const f32x4 (&acc)[2][2][4][2], const Unit& u, int, int, int, int) const {
        const int tile = isv * 16 + u.pm; float* part = (float*)(wsb + 172 * MiB) + (size_t)tile * 65536; unsigned* flag = (unsigned*)(wsb + 49152) + 64 * tile;
        f32x4* p = (f32x4*)part + threadIdx.x;
#pragma unroll
        for (int ai = 0; ai < 2; ++ai)
#pragma unroll
            for (int bj = 0; bj < 2; ++bj)
#pragma unroll
                for (int m = 0; m < 4; ++m)
#pragma unroll
                    for (int n = 0; n < 2; ++n) p[(size_t)(((ai * 2 + bj) * 4 + m) * 2 + n) * 512] = acc[ai][bj][m][n];
        asm volatile("s_waitcnt vmcnt(0)" ::: "memory");
        __syncthreads();
        if (threadIdx.x == 0) { __builtin_amdgcn_fence(__ATOMIC_RELEASE, "agent"); asm volatile("s_waitcnt vmcnt(0)" ::: "memory");
            __hip_atomic_store(flag, 1u, __ATOMIC_RELAXED, __HIP_MEMORY_SCOPE_AGENT); }
    }
};
struct EpiCompress {
    static constexpr bool PERM = true, AFTER_DRAIN = true;
    const bf16_t* W2T;
    bf16_t* OUT;
    const float* kg;
    unsigned char* wsb;
    __device__ __forceinline__ void fused(f32x4 (&acc)[2][2][4][2], const Unit& u, int wr, int wc, int fr, int fq, PG8_LAS unsigned char* lds, int wid, int lane) const {
        constexpr int HP = 528;
        {
            const int tile = (kg ? 0 : 16) + u.pm; const float* part = (const float*)(wsb + 172 * MiB) + (size_t)tile * 65536; unsigned* flag = (unsigned*)(wsb + 49152) + 64 * tile;
            if (threadIdx.x == 0) { while (__hip_atomic_load(flag, __ATOMIC_RELAXED, __HIP_MEMORY_SCOPE_AGENT) == 0u) __builtin_amdgcn_s_sleep(1);
                __builtin_amdgcn_fence(__ATOMIC_ACQUIRE, "agent"); asm volatile("s_waitcnt vmcnt(0)" ::: "memory"); }
            __syncthreads();
            const f32x4* p = (const f32x4*)part + threadIdx.x;
#pragma unroll
            for (int ai = 0; ai < 2; ++ai)
#pragma unroll
                for (int bj = 0; bj < 2; ++bj) {
                    f32x4 t[4][2];
#pragma unroll
                    for (int m = 0; m < 4; ++m)
#pragma unroll
                        for (int n = 0; n < 2; ++n) t[m][n] = p[(size_t)(((ai * 2 + bj) * 4 + m) * 2 + n) * 512];
#pragma unroll
                    for (int m = 0; m < 4; ++m)
#pragma unroll
                        for (int n = 0; n < 2; ++n) acc[ai][bj][m][n] = acc[ai][bj][m][n] + t[m][n];
                    asm volatile("" ::: "memory"); }
        }
#pragma unroll
        for (int ai = 0; ai < 2; ++ai)
#pragma unroll
            for (int m = 0; m < 4; ++m) { const int r = wr * 128 + ai * 64 + m * 16 + fr;
#pragma unroll
                for (int bj = 0; bj < 2; ++bj) { const f32x4 v0 = acc[ai][bj][m][0], v1 = acc[ai][bj][m][1];
                    *(PG8_LAS u32x4*)(lds + r * HP + (bj * 128 + wc * 32 + 8 * fq) * 2) = pack8((f32x4){gelu_tanh(v0[0]), gelu_tanh(v0[1]), gelu_tanh(v0[2]), gelu_tanh(v0[3])}, (f32x4){gelu_tanh(v1[0]), gelu_tanh(v1[1]), gelu_tanh(v1[2]), gelu_tanh(v1[3])}); } }
        asm volatile("s_waitcnt lgkmcnt(0)" ::: "memory"); __builtin_amdgcn_s_barrier(); asm volatile("" ::: "memory");
        typedef float f32x16_ __attribute__((ext_vector_type(16)));
        const int r32 = lane & 31, hi = lane >> 5;
        f32x16_ o0 = (f32x16_){0.f, 0.f, 0.f, 0.f, 0.f, 0.f, 0.f, 0.f, 0.f, 0.f, 0.f, 0.f, 0.f, 0.f, 0.f, 0.f}, o1 = o0;
        const PG8_LAS unsigned char* hb = lds + (32 * wid + r32) * HP + 16 * hi;
        const bf16_t* wa = W2T + (size_t)r32 * 256 + 8 * hi;
#pragma unroll 4
        for (int ks = 0; ks < 16; ++ks) { const bf16x8 hf = *(const PG8_LAS bf16x8*)(hb + 32 * ks);
            o0 = __builtin_amdgcn_mfma_f32_32x32x16_bf16(*(const bf16x8*)(wa + 16 * ks), hf, o0, 0, 0, 0);
            o1 = __builtin_amdgcn_mfma_f32_32x32x16_bf16(*(const bf16x8*)(wa + 32 * 256 + 16 * ks), hf, o1, 0, 0, 0); }
        float rs = 1.0f;
        if (kg) { float ss = 0.f;
#pragma unroll
            for (int r = 0; r < 16; ++r) ss += o0[r] * o0[r] + o1[r] * o1[r];
            ss += __shfl_xor(ss, 32); rs = rsqrtf(ss * (1.f / 64.f) + 1e-6f); }
        const int R = u.pm * BM + 32 * wid + r32;
        if (R < 4080) { const int g = R & 1, bc = R >> 1, b = bc / 255, c = bc - b * 255; bf16_t* op = OUT + ((size_t)(b * 2 + g) * 256 + c) * 64 + 4 * hi;
#pragma unroll
            for (int q = 0; q < 4; ++q) { f32x4 a0 = (f32x4){o0[4 * q], o0[4 * q + 1], o0[4 * q + 2], o0[4 * q + 3]} * rs, a1 = (f32x4){o1[4 * q], o1[4 * q + 1], o1[4 * q + 2], o1[4 * q + 3]} * rs;
                if (kg) { a0 = a0 * *(const f32x4*)(kg + 8 * q + 4 * hi); a1 = a1 * *(const f32x4*)(kg + 32 + 8 * q + 4 * hi); }
                typedef unsigned u32x2_ __attribute__((ext_vector_type(2)));
                u32x2_ w0; w0.x = cvt_pk_bf16(a0[0], a0[1]); w0.y = cvt_pk_bf16(a0[2], a0[3]); u32x2_ w1; w1.x = cvt_pk_bf16(a1[0], a1[1]); w1.y = cvt_pk_bf16(a1[2], a1[3]);
                *(u32x2_*)(op + 8 * q) = w0; *(u32x2_*)(op + 32 + 8 * q) = w1; } }
    }
};
template <int MODE> struct EpiMerge {
    static constexpr bool PERM = true, AFTER_DRAIN = false;
    const bf16_t* G; bf16_t* O;
    __device__ __forceinline__ void operator()(const f32x4 (&acc)[2][2][4][2], const Unit& u, int wr, int wc, int fr, int fq) const {
        const int row0 = u.pm * BM + wr * 128 + fr, col0 = u.pn * BM + wc * 32 + 8 * fq;
#pragma unroll
        for (int ai = 0; ai < 2; ++ai) {
            u32x4 gq[4][2], oq[4][2];
#pragma unroll
            for (int m = 0; m < 4; ++m) { const size_t off = (size_t)(row0 + ai * 64 + m * 16) * 1024 + col0;
#pragma unroll
                for (int bj = 0; bj < 2; ++bj) { gq[m][bj] = *(const u32x4*)(G + off + bj * HALF); if (MODE == 1) oq[m][bj] = *(const u32x4*)(O + off + bj * HALF); } }
#pragma unroll
            for (int m = 0; m < 4; ++m) { const size_t off = (size_t)(row0 + ai * 64 + m * 16) * 1024 + col0;
#pragma unroll
                for (int bj = 0; bj < 2; ++bj) { const u32x4 g = gq[m][bj];
                    f32x4 v0 = acc[ai][bj][m][0], v1 = acc[ai][bj][m][1];
                    v0 = v0 * (f32x4){blo(g.x), bhi(g.x), blo(g.y), bhi(g.y)}; v1 = v1 * (f32x4){blo(g.z), bhi(g.z), blo(g.w), bhi(g.w)};
                    if (MODE == 1) { const u32x4 o = oq[m][bj];
                        v0 = v0 + (f32x4){blo(o.x), bhi(o.x), blo(o.y), bhi(o.y)}; v1 = v1 + (f32x4){blo(o.z), bhi(o.z), blo(o.w), bhi(o.w)}; }
                    *(u32x4*)(O + off + bj * HALF) = pack8(v0, v1); } } }
    }
};
struct EpiResid {
    static constexpr bool PERM = false, AFTER_DRAIN = false;
    const float* base; float* out;
    __device__ __forceinline__ void operator()(const f32x4 (&acc)[2][2][4][2], const Unit& u, int wr, int wc, int fr, int fq) const {
        const int row0 = u.pm * BM + wr * 128 + fr, col0 = u.pn * BM + wc * 32 + 4 * fq;
#pragma unroll
        for (int ai = 0; ai < 2; ++ai)
#pragma unroll
            for (int m = 0; m < 4; ++m) { const size_t off = (size_t)(row0 + ai * 64 + m * 16) * 1024 + col0;
#pragma unroll
                for (int bj = 0; bj < 2; ++bj)
#pragma unroll
                    for (int n = 0; n < 2; ++n) { const f32x4 b = *(const f32x4*)(base + off + bj * HALF + n * 16); *(f32x4*)(out + off + bj * HALF + n * 16) = b + acc[ai][bj][m][n]; } }
    }
};
#define XBLK_BASE(u, wr, wc, fr, fq) ((((size_t)(u).pm * 16 + (u).pn * 4 + ((wc) >> 1)) * 256 + ((wr) * 128 + (fr))) * 64 + ((wc) & 1) * 32 + 4 * (fq))
#define XBLK_PIECE(ai, m, bj, n) ((bj) * 32768 + (ai) * 4096 + (m) * 1024 + (n) * 16)
struct EpiResidB {
    static constexpr bool PERM = false, AFTER_DRAIN = false;
    const bf16_t* base; float* out;
    __device__ __forceinline__ void operator()(const f32x4 (&acc)[2][2][4][2], const Unit& u, int wr, int wc, int fr, int fq) const {
        const int row0 = u.pm * BM + wr * 128 + fr, col0 = u.pn * BM + wc * 32 + 4 * fq;
        typedef unsigned u32x2_ __attribute__((ext_vector_type(2)));
        const bf16_t* const xb0 = base + XBLK_BASE(u, wr, wc, fr, fq);
        u32x2_ rb[2][4][2][2];
#pragma unroll
        for (int ai = 0; ai < 2; ++ai)
#pragma unroll
            for (int m = 0; m < 4; ++m) { const size_t off = (size_t)(row0 + ai * 64 + m * 16) * 1024 + col0;
#pragma unroll
                for (int bj = 0; bj < 2; ++bj)
#pragma unroll
                    for (int n = 0; n < 2; ++n) rb[ai][m][bj][n] = *(const u32x2_*)(xb0 + XBLK_PIECE(ai, m, bj, n)); }
#pragma unroll
        for (int ai = 0; ai < 2; ++ai)
#pragma unroll
            for (int m = 0; m < 4; ++m) { const size_t off = (size_t)(row0 + ai * 64 + m * 16) * 1024 + col0;
#pragma unroll
                for (int bj = 0; bj < 2; ++bj)
#pragma unroll
                    for (int n = 0; n < 2; ++n) { const u32x2_ b = rb[ai][m][bj][n]; *(f32x4*)(out + off + bj * HALF + n * 16) = (f32x4){blo(b.x), bhi(b.x), blo(b.y), bhi(b.y)} + acc[ai][bj][m][n]; } }
    }
};
struct EpiResidNorm {
    static constexpr bool PERM = false, AFTER_DRAIN = false;
    const float* base; float* out; bf16_t* XB; float* PS;
    __device__ __forceinline__ void operator()(const f32x4 (&acc)[2][2][4][2], const Unit& u, int wr, int wc, int fr, int fq) const {
        const int row0 = u.pm * BM + wr * 128 + fr, col0 = u.pn * BM + wc * 32 + 4 * fq;
        typedef unsigned u32x2_ __attribute__((ext_vector_type(2)));
        bf16_t* const xb0 = XB + XBLK_BASE(u, wr, wc, fr, fq);
#pragma unroll
        for (int ai = 0; ai < 2; ++ai) {
            f32x4 xr[4][2][2];
#pragma unroll
            for (int m = 0; m < 4; ++m) { const size_t off = (size_t)(row0 + ai * 64 + m * 16) * 1024 + col0;
#pragma unroll
                for (int bj = 0; bj < 2; ++bj)
#pragma unroll
                    for (int n = 0; n < 2; ++n) xr[m][bj][n] = *(const f32x4*)(base + off + bj * HALF + n * 16); }
#pragma unroll
            for (int m = 0; m < 4; ++m) { const int row = row0 + ai * 64 + m * 16; const size_t off = (size_t)row * 1024 + col0; float ss = 0.f;
#pragma unroll
                for (int bj = 0; bj < 2; ++bj)
#pragma unroll
                    for (int n = 0; n < 2; ++n) { const f32x4 v = xr[m][bj][n] + acc[ai][bj][m][n];
                        u32x2_ w; w.x = cvt_pk_bf16(v[0], v[1]); w.y = cvt_pk_bf16(v[2], v[3]); *(u32x2_*)(xb0 + XBLK_PIECE(ai, m, bj, n)) = w;
                        ss += (v[0] * v[0] + v[1] * v[1]) + (v[2] * v[2] + v[3] * v[3]); }
                ss += __shfl_xor(ss, 16); ss += __shfl_xor(ss, 32);
                if (fq == 0) PS[(size_t)row * 16 + u.pn * 4 + wc] = ss; } }
    }
};
#ifndef USE_DPP
#define USE_DPP 1
#endif
__device__ __forceinline__ float dpp_prev1(float cur, float prv) {
#if USE_DPP
    const int t = __builtin_amdgcn_update_dpp(0, __float_as_int(prv), 0x10F  , 0xF, 0xF, true);
    return __int_as_float(__builtin_amdgcn_update_dpp(t, __float_as_int(cur), 0x111  , 0xF, 0xF, false));
#else
    const int lane = threadIdx.x & 63; const float a = __shfl(cur, lane - 1), b = __shfl(prv, lane + 15); return (lane & 15) >= 1 ? a : b;
#endif
}
__device__ __forceinline__ float dpp_prev2(float cur, float prv) {
#if USE_DPP
    const int t = __builtin_amdgcn_update_dpp(0, __float_as_int(prv), 0x10E  , 0xF, 0xF, true);
    return __int_as_float(__builtin_amdgcn_update_dpp(t, __float_as_int(cur), 0x112  , 0xF, 0xF, false));
#else
    const int lane = threadIdx.x & 63; const float a = __shfl(cur, lane - 2), b = __shfl(prv, lane + 14); return (lane & 15) >= 2 ? a : b;
#endif
}
struct EpiUpConv {
    static constexpr bool PERM = true, AFTER_DRAIN = false;
    bf16_t* ACT; float* U4; const float* cw; const float* cb; const float* PS; PG8_LAS unsigned char* rstd_lds;
    __device__ __forceinline__ void operator()(const f32x4 (&acc)[2][2][4][2], const Unit& u, int wr, int wc, int fr, int fq) const {
        const int row0 = u.pm * BM + wr * 128 + fr;
        const int cv0 = u.pn * 128 + wc * 32 + 8 * fq;
        const int blk = u.pm * 2 + wr;
        bf16_t* const actb = ACT + (((size_t)u.pm * 44 + 2 * u.pn + (wc >> 1)) * 256 + wr * 128 + fr) * 64 + (wc & 1) * 32 + 8 * fq;
        f32x4 (&A)[2][2][4][2] = const_cast<f32x4 (&)[2][2][4][2]>(acc);
        {   const PG8_LAS int* tg = (const PG8_LAS int*)((PG8_LAS float*)rstd_lds + 512); const PG8_LAS float* rt = (const PG8_LAS float*)rstd_lds + (tg[0] == u.pm ? 0 : 256);
#pragma unroll
            for (int mm = 0; mm < 8; ++mm) { const float rs = rt[wr * 128 + mm * 16 + fr];
#pragma unroll
                for (int bj = 0; bj < 2; ++bj)
#pragma unroll
                    for (int n = 0; n < 2; ++n) A[mm >> 2][bj][mm & 3][n] = A[mm >> 2][bj][mm & 3][n] * rs; }
        }
#pragma unroll
        for (int n = 0; n < 2; ++n) {
            f32x4 w0[2], w1[2], w2[2], bb[2];
#pragma unroll
            for (int bj = 0; bj < 2; ++bj) { const int c = bj * 2816 + cv0 + 4 * n;
                w0[bj] = *(const f32x4*)(cw + c); w1[bj] = *(const f32x4*)(cw + 5632 + c); w2[bj] = *(const f32x4*)(cw + 2 * 5632 + c); bb[bj] = *(const f32x4*)(cb + c); }
            {   const int tc = u.pn * 256 + wc * 32 + 8 * fq + 4 * n;
                if (fr < 2) {
#pragma unroll
                    for (int bj = 0; bj < 2; ++bj) *(f32x4*)(U4 + ((size_t)blk * 4 + fr) * 5632 + tc + bj * 128) = acc[0][bj][0][n]; }
                if (fr >= 14) {
#pragma unroll
                    for (int bj = 0; bj < 2; ++bj) *(f32x4*)(U4 + ((size_t)blk * 4 + 2 + (fr - 14)) * 5632 + tc + bj * 128) = acc[1][bj][3][n]; }
            }
#pragma unroll
            for (int mm = 0; mm < 8; ++mm) { const int ai = mm >> 2, m = mm & 3;
                f32x4 c[2];
#pragma unroll
                for (int bj = 0; bj < 2; ++bj) {
                    const f32x4 cur = acc[ai][bj][m][n]; const f32x4 prv = (mm == 0) ? (f32x4){0.f, 0.f, 0.f, 0.f} : acc[(mm - 1) >> 2][bj][(mm - 1) & 3][n];
#pragma unroll
                    for (int e = 0; e < 4; ++e) c[bj][e] = fmaf(w2[bj][e], cur[e], bb[bj][e]);
                    {   float c0 = c[bj][0], c1 = c[bj][1], c2 = c[bj][2], c3 = c[bj][3];
                        asm volatile("s_nop 1\n\t"
                                     "v_fmac_f32_dpp %0, %4, %8 row_shr:1 row_mask:0xf bank_mask:0xf bound_ctrl:1\n\tv_fmac_f32_dpp %1, %5, %9 row_shr:1 row_mask:0xf bank_mask:0xf bound_ctrl:1\n\t"
                                     "v_fmac_f32_dpp %2, %6, %10 row_shr:1 row_mask:0xf bank_mask:0xf bound_ctrl:1\n\tv_fmac_f32_dpp %3, %7, %11 row_shr:1 row_mask:0xf bank_mask:0xf bound_ctrl:1\n\t"
                                     "v_fmac_f32_dpp %0, %4, %12 row_shr:2 row_mask:0xf bank_mask:0xf bound_ctrl:1\n\tv_fmac_f32_dpp %1, %5, %13 row_shr:2 row_mask:0xf bank_mask:0xf bound_ctrl:1\n\t"
                                     "v_fmac_f32_dpp %2, %6, %14 row_shr:2 row_mask:0xf bank_mask:0xf bound_ctrl:1\n\tv_fmac_f32_dpp %3, %7, %15 row_shr:2 row_mask:0xf bank_mask:0xf bound_ctrl:1"
                                     : "+v"(c0), "+v"(c1), "+v"(c2), "+v"(c3)
                                     : "v"(cur[0]), "v"(cur[1]), "v"(cur[2]), "v"(cur[3]), "v"(w1[bj][0]), "v"(w1[bj][1]), "v"(w1[bj][2]), "v"(w1[bj][3]), "v"(w0[bj][0]), "v"(w0[bj][1]), "v"(w0[bj][2]), "v"(w0[bj][3]));
                        if (mm > 0)
                            asm volatile("s_nop 1\n\t"
                                     "v_fmac_f32_dpp %0, %4, %8 row_shl:15 row_mask:0xf bank_mask:0xf bound_ctrl:1\n\tv_fmac_f32_dpp %1, %5, %9 row_shl:15 row_mask:0xf bank_mask:0xf bound_ctrl:1\n\t"
                                     "v_fmac_f32_dpp %2, %6, %10 row_shl:15 row_mask:0xf bank_mask:0xf bound_ctrl:1\n\tv_fmac_f32_dpp %3, %7, %11 row_shl:15 row_mask:0xf bank_mask:0xf bound_ctrl:1\n\t"
                                     "v_fmac_f32_dpp %0, %4, %12 row_shl:14 row_mask:0xf bank_mask:0xf bound_ctrl:1\n\tv_fmac_f32_dpp %1, %5, %13 row_shl:14 row_mask:0xf bank_mask:0xf bound_ctrl:1\n\t"
                                     "v_fmac_f32_dpp %2, %6, %14 row_shl:14 row_mask:0xf bank_mask:0xf bound_ctrl:1\n\tv_fmac_f32_dpp %3, %7, %15 row_shl:14 row_mask:0xf bank_mask:0xf bound_ctrl:1"
                                     : "+v"(c0), "+v"(c1), "+v"(c2), "+v"(c3)
                                     : "v"(prv[0]), "v"(prv[1]), "v"(prv[2]), "v"(prv[3]), "v"(w1[bj][0]), "v"(w1[bj][1]), "v"(w1[bj][2]), "v"(w1[bj][3]), "v"(w0[bj][0]), "v"(w0[bj][1]), "v"(w0[bj][2]), "v"(w0[bj][3]));
                        c[bj][0] = c0; c[bj][1] = c1; c[bj][2] = c2; c[bj][3] = c3; } }
                f32x4 a;
#pragma unroll
                for (int e = 0; e < 4; ++e) a[e] = c[1][e] * sigm(c[1][e]) * c[0][e];
                u32x2 w; w.x = cvt_pk_bf16(a[0], a[1]); w.y = cvt_pk_bf16(a[2], a[3]);
                if (mm > 0 || fr >= 2) *(u32x2*)(actb + mm * 1024 + 4 * n) = w;
            }
        }
    }
};
template <class Epi, class Sched, bool ALIGN_EPI = false, bool SP2 = false>
__device__ __forceinline__ void gemm_phase(PG8_LAS unsigned char* lds, const Gemm g, const Sched& S, const Epi& E) {
    const int tid = threadIdx.x, wid = __builtin_amdgcn_readfirstlane(tid >> 6), lane = tid & 63, wr = wid >> 2, wc = wid & 3, fr = lane & 15, fq = lane >> 4;
    const int nt = g.K / BK, K = g.ld ? g.ld : g.K;
    unsigned voffA[2], voffB[2];
#pragma unroll
    for (int i = 0; i < 2; ++i) { int R, C; stage_rc(tid * 16 + i * 8192, R, C); const int Rb = Epi::PERM ? ((R & ~31) + perm32(R & 31)) : R;
        voffA[i] = (unsigned)((128 * (R >> 6) + (R & 63)) * (g.ablk ? BK : K) + C) * 2u; voffB[i] = (unsigned)(Rb * K + C) * 2u; }
    const size_t kstep = (size_t)(BK * 2);
    const size_t hstep = (size_t)HALF * K * 2;
    const size_t hstepA = (size_t)64 * (g.ablk ? BK : K) * 2;
    const size_t kstepA = g.ablk ? (size_t)256 * BK * 2 : kstep;
    const size_t tstep = 2 * hstep;
    const unsigned ldsw = (unsigned)wid * 1024u;
    const int aoff = lds_byte(wr * 64 + fr, fq * 8), boff = lds_byte(wc * 32 + fr, fq * 8);
#define PG8_SA(b, h) (((b) * 2 + (h)) * HTB)
#define PG8_SB(b, h) ((4 + (b) * 2 + (h)) * HTB)
#define PG8_STAGE(bufoff, gbase, voff) do { _Pragma("unroll") for (int _i = 0; _i < 2; ++_i) \
        __builtin_amdgcn_global_load_lds((const unsigned*)((const char*)(gbase) + (voff)[_i]), (PG8_LAS unsigned*)(lds + (bufoff) + ldsw + _i * 8192), 16, 0, 0); } while (0)
#define PG8_LDA(dst, b, h) do { _Pragma("unroll") for (int m = 0; m < 4; ++m) _Pragma("unroll") for (int k = 0; k < 2; ++k) dst[m][k] = *(const PG8_LAS bf16x8*)(lds + PG8_SA(b, h) + aoff + m * 2048 + k * 1024); } while (0)
#define PG8_LDB(dst, b, h) do { _Pragma("unroll") for (int n = 0; n < 2; ++n) _Pragma("unroll") for (int k = 0; k < 2; ++k) dst[n][k] = *(const PG8_LAS bf16x8*)(lds + PG8_SB(b, h) + boff + n * 2048 + k * 1024); } while (0)
#define PG8_MMA(ai, bj, At, Bt) do { __builtin_amdgcn_s_setprio(1); _Pragma("unroll") for (int m = 0; m < 4; ++m) _Pragma("unroll") for (int n = 0; n < 2; ++n) _Pragma("unroll") for (int k = 0; k < 2; ++k) \
        acc[ai][bj][m][n] = __builtin_amdgcn_mfma_f32_16x16x32_bf16(Bt[n][k], At[m][k], acc[ai][bj][m][n], 0, 0, 0); __builtin_amdgcn_s_setprio(0); } while (0)
#define PG8_WAIT_V(n) asm volatile("s_waitcnt vmcnt(" #n ")" ::: "memory")
#define PG8_WAIT_L(n) asm volatile("s_waitcnt lgkmcnt(" #n ")" ::: "memory")
#define PG8_BAR __builtin_amdgcn_s_barrier()
#define PG8_SCHED __builtin_amdgcn_sched_barrier(0)
    Unit cur, nxt; int ui = 0;
    if (!S.next(0, cur)) return;
    f32x4 acc[2][2][4][2];
#pragma unroll
    for (int a = 0; a < 2; ++a)
#pragma unroll
        for (int b = 0; b < 2; ++b)
#pragma unroll
            for (int m = 0; m < 4; ++m)
#pragma unroll
                for (int n = 0; n < 2; ++n) acc[a][b][m][n] = (f32x4){0.f, 0.f, 0.f, 0.f};
    bf16x8 At[4][2], B0[2][2], B1[2][2];
    const char* cA = (const char*)g.A + (size_t)cur.pm * tstep; const char* cB = (const char*)g.Bt + (size_t)cur.pn * tstep;
    S.a_ready(cur);
    if constexpr (SP2) {
        PG8_STAGE(PG8_SB(0, 0), cB, voffB); PG8_STAGE(PG8_SB(0, 1), cB + hstep, voffB); PG8_STAGE(PG8_SA(0, 0), cA, voffA); PG8_STAGE(PG8_SA(0, 1), cA + hstepA, voffA);
        if (wr == 1) PG8_BAR;
        PG8_WAIT_V(2); PG8_BAR;
        PG8_STAGE(PG8_SB(1, 0), cB + kstep, voffB); PG8_STAGE(PG8_SA(1, 0), cA + kstepA, voffA); PG8_STAGE(PG8_SB(1, 1), cB + hstep + kstep, voffB);
        PG8_WAIT_V(6); PG8_BAR;
    } else {
        PG8_STAGE(PG8_SB(0, 0), cB, voffB); PG8_STAGE(PG8_SA(0, 0), cA, voffA); PG8_STAGE(PG8_SB(0, 1), cB + hstep, voffB); PG8_STAGE(PG8_SA(0, 1), cA + hstepA, voffA);
        if (wr == 1) PG8_BAR;
        PG8_WAIT_V(4); PG8_BAR;
        PG8_STAGE(PG8_SB(1, 0), cB + kstep, voffB); PG8_STAGE(PG8_SA(1, 0), cA + kstepA, voffA); PG8_STAGE(PG8_SB(1, 1), cB + hstep + kstep, voffB);
        PG8_WAIT_V(6); PG8_BAR;
    }
    for (;;) {
        const bool has_next = S.next(ui + 1, nxt);
        const char* nA = has_next ? (const char*)g.A + (size_t)nxt.pm * tstep : cA; const char* nB = has_next ? (const char*)g.Bt + (size_t)nxt.pn * tstep : cB;
        for (int t = 0; t < nt; t += 2) {
            const bool last = (t == nt - 2);
            const char* a1 = cA + (size_t)(t + 1) * kstepA;
            const char* a2 = last ? nA : cA + (size_t)(t + 2) * kstepA; const char* b2 = last ? nB : cB + (size_t)(t + 2) * kstep;
            const char* a3 = a2 + kstepA; const char* b3 = b2 + kstep;
            if (last && has_next) S.a_ready(nxt);
            if constexpr (SP2) {
            PG8_LDB(B0, 0, 0); PG8_LDB(B1, 0, 1); PG8_SCHED; PG8_LDA(At, 0, 0); PG8_STAGE(PG8_SA(1, 1), a1 + hstepA, voffA);
            PG8_WAIT_V(8); PG8_WAIT_L(0); PG8_BAR; PG8_MMA(0, 0, At, B0); PG8_MMA(0, 1, At, B1); PG8_BAR; PG8_SCHED;
            PG8_LDA(At, 0, 1); PG8_STAGE(PG8_SB(0, 0), b2, voffB); PG8_STAGE(PG8_SB(0, 1), b2 + hstep, voffB); PG8_STAGE(PG8_SA(0, 0), a2, voffA);
            PG8_WAIT_V(8); PG8_WAIT_L(0); PG8_BAR; PG8_MMA(1, 0, At, B0); PG8_MMA(1, 1, At, B1); PG8_BAR; PG8_SCHED;
            PG8_LDB(B0, 1, 0); PG8_LDB(B1, 1, 1); PG8_SCHED; PG8_LDA(At, 1, 0); PG8_STAGE(PG8_SA(0, 1), a2 + hstepA, voffA);
            PG8_WAIT_V(8); PG8_WAIT_L(0); PG8_BAR; PG8_MMA(0, 0, At, B0); PG8_MMA(0, 1, At, B1); PG8_BAR; PG8_SCHED;
            PG8_LDA(At, 1, 1); PG8_STAGE(PG8_SB(1, 0), b3, voffB); PG8_STAGE(PG8_SB(1, 1), b3 + hstep, voffB); PG8_STAGE(PG8_SA(1, 0), a3, voffA);
            PG8_WAIT_V(8); PG8_WAIT_L(0); PG8_BAR; PG8_MMA(1, 0, At, B0); PG8_MMA(1, 1, At, B1); PG8_BAR; PG8_SCHED;
            } else {
            PG8_LDB(B0, 0, 0); PG8_SCHED; PG8_LDA(At, 0, 0); PG8_STAGE(PG8_SA(1, 1), a1 + hstepA, voffA);
            PG8_WAIT_L(8); PG8_BAR; PG8_WAIT_L(0); PG8_MMA(0, 0, At, B0); PG8_BAR; PG8_SCHED;
            PG8_LDB(B1, 0, 1); PG8_STAGE(PG8_SB(0, 0), b2, voffB);
            PG8_BAR; PG8_WAIT_L(0); PG8_MMA(0, 1, At, B1); PG8_BAR;
            PG8_LDA(At, 0, 1); PG8_STAGE(PG8_SA(0, 0), a2, voffA);
            PG8_BAR; PG8_WAIT_L(0); PG8_MMA(1, 0, At, B0); PG8_BAR; PG8_SCHED;
            PG8_STAGE(PG8_SB(0, 1), b2 + hstep, voffB);
            PG8_WAIT_V(6); PG8_BAR; PG8_MMA(1, 1, At, B1); PG8_BAR;
            PG8_LDB(B0, 1, 0); PG8_SCHED; PG8_LDA(At, 1, 0); PG8_STAGE(PG8_SA(0, 1), a2 + hstepA, voffA);
            PG8_WAIT_L(8); PG8_BAR; PG8_WAIT_L(0); PG8_MMA(0, 0, At, B0); PG8_BAR; PG8_SCHED;
            PG8_LDB(B1, 1, 1); PG8_STAGE(PG8_SB(1, 0), b3, voffB);
            PG8_BAR; PG8_WAIT_L(0); PG8_MMA(0, 1, At, B1); PG8_BAR;
            PG8_LDA(At, 1, 1); PG8_STAGE(PG8_SA(1, 0), a3, voffA);
            PG8_BAR; PG8_WAIT_L(0); PG8_MMA(1, 0, At, B0); PG8_BAR; PG8_SCHED;
            PG8_STAGE(PG8_SB(1, 1), b3 + hstep, voffB);
            PG8_WAIT_V(6); PG8_BAR; PG8_MMA(1, 1, At, B1); PG8_BAR;
            }
        }
        if constexpr (ALIGN_EPI) { if (wr == 0) PG8_BAR; }
        if constexpr (!Epi::AFTER_DRAIN) { E(acc, cur, wr, wc, fr, fq); S.done(cur); }
        if (!has_next) break;
#pragma unroll
        for (int a = 0; a < 2; ++a)
#pragma unroll
            for (int b = 0; b < 2; ++b)
#pragma unroll
                for (int m = 0; m < 4; ++m)
#pragma unroll
                    for (int n = 0; n < 2; ++n) acc[a][b][m][n] = (f32x4){0.f, 0.f, 0.f, 0.f};
        cur = nxt; cA = nA; cB = nB; ++ui;
        if constexpr (ALIGN_EPI) { if (wr == 1) PG8_BAR; }
    }
    PG8_WAIT_V(0);
    if constexpr (!ALIGN_EPI) { if (wr == 0) PG8_BAR; }
    PG8_BAR;
    if constexpr (Epi::AFTER_DRAIN) { E.fused(acc, cur, wr, wc, fr, fq, lds, wid, lane); S.done(cur); }
#undef PG8_SA
#undef PG8_SB
#undef PG8_STAGE
#undef PG8_LDA
#undef PG8_LDB
#undef PG8_MMA
#undef PG8_WAIT_V
#undef PG8_WAIT_L
#undef PG8_BAR
#undef PG8_SCHED
}
}
#ifndef PG8_SP2
#define PG8_SP2 true
#endif
#ifndef PG8_ALIGN
#define PG8_ALIGN true
#endif

struct Args {
    const float* in[31]; float* out; unsigned char* ws;
    int ph_lo, ph_hi;
};
enum InIdx { I_X = 0, I_ANG, I_WIN, I_RELB, I_QNG, I_KNG, I_PEK, I_W1K, I_W2K, I_PEV, I_W1V, I_W2V, I_MU, I_W0, I_W2, I_A0, I_A2, I_G2, I_KK, I_KA, I_RK, I_LNG, I_LNB,
             I_WPA, I_WPB, I_WOUT, I_FNG, I_WUP, I_CW, I_CB, I_WDN };

#define LDS_WAIT() asm volatile("s_waitcnt lgkmcnt(0)" ::: "memory")
#define VM_WAIT() asm volatile("s_waitcnt vmcnt(0)" ::: "memory")

__device__ __forceinline__ int srccol(int mode, int nd) {
    if (mode == 1) {
        if (nd < 1280) { const int t = nd >> 8, p = nd & 255; return 256 * t + 64 * ((p >> 5) & 3) + 32 * (p >> 7) + (p & 31); }
        if (nd < 5120) return nd + 24; if (nd < 5144) return 1280 + (nd - 5120); return -1; }
    if (mode == 2) {
        const int pn = nd >> 8, r = nd & 255; return (r >> 7) * 2816 + pn * 128 + (r & 127); }
    return nd;
}
__device__ __forceinline__ void tr_item(const float* W, int Nsrc, bf16_t* WT, int K, LAS float* scr, int kb, int nb, int lane, int mode, const float* rscale = nullptr) {
    const int k0 = 64 * kb, n0 = 32 * nb; const int sc = srccol(mode, n0 + (lane & 31));
    const int scc = sc >= 0 ? sc : 0; const float* wp = W + (size_t)(k0 + (lane >> 5)) * Nsrc + scc; float v[32];
#pragma unroll
    for (int i = 0; i < 32; ++i) v[i] = wp[(size_t)(2 * i) * Nsrc];
    if (rscale) { const float* rp = rscale + k0 + (lane >> 5); float rs[32];
#pragma unroll
        for (int i = 0; i < 32; ++i) rs[i] = rp[2 * i];
#pragma unroll
        for (int i = 0; i < 32; ++i) v[i] *= rs[i]; }
#pragma unroll
    for (int i = 0; i < 32; ++i) scr[(2 * i + (lane >> 5)) * 33 + (lane & 31)] = sc >= 0 ? v[i] : 0.f;
    LDS_WAIT(); asm volatile("" ::: "memory");
    const int c = lane & 7;
#pragma unroll
    for (int j = 0; j < 4; ++j) { const int n = (lane >> 3) + 8 * j; const LAS float* s = scr + (8 * c) * 33 + n;
        u32x4 o; o.x = pk2(s[0 * 33], s[1 * 33]); o.y = pk2(s[2 * 33], s[3 * 33]); o.z = pk2(s[4 * 33], s[5 * 33]); o.w = pk2(s[6 * 33], s[7 * 33]);
        *(u32x4*)(WT + (size_t)(n0 + n) * K + k0 + 8 * c) = o; }
    LDS_WAIT(); asm volatile("" ::: "memory");
}
__device__ __forceinline__ void rms_rows2_to_bf16(const float* x0, const float* x1, const float* g, bf16_t* o0, bf16_t* o1, int lane) {
    const f32x4* xa = (const f32x4*)x0 + lane; const f32x4* xb = (const f32x4*)x1 + lane; const f32x4* gr = (const f32x4*)g + lane;
    f32x4 va[4], vb[4]; float sa = 0.f, sb = 0.f;
#pragma unroll
    for (int j = 0; j < 4; ++j) { va[j] = xa[64 * j]; vb[j] = xb[64 * j]; }
#pragma unroll
    for (int j = 0; j < 4; ++j) { sa += (va[j].x * va[j].x + va[j].y * va[j].y) + (va[j].z * va[j].z + va[j].w * va[j].w); sb += (vb[j].x * vb[j].x + vb[j].y * vb[j].y) + (vb[j].z * vb[j].z + vb[j].w * vb[j].w); }
    const float ra = rsqrtf(wave_sum(sa) * (1.f / 1024.f) + RMS_EPS), rb = rsqrtf(wave_sum(sb) * (1.f / 1024.f) + RMS_EPS);
    unsigned long long* oa = (unsigned long long*)o0 + lane; unsigned long long* ob = (unsigned long long*)o1 + lane;
#pragma unroll
    for (int j = 0; j < 4; ++j) { const f32x4 gg = gr[64 * j];
        oa[64 * j] = (unsigned long long)pk2(va[j].x * ra * gg.x, va[j].y * ra * gg.y) | ((unsigned long long)pk2(va[j].z * ra * gg.z, va[j].w * ra * gg.w) << 32);
        ob[64 * j] = (unsigned long long)pk2(vb[j].x * rb * gg.x, vb[j].y * rb * gg.y) | ((unsigned long long)pk2(vb[j].z * rb * gg.z, vb[j].w * rb * gg.w) << 32); }
}
__device__ __forceinline__ void prologue_early_items(const Args& a, LAS float* scr, int gw, int NGW, int lane) {
    constexpr int I0 = 16 * 168, I6 = 32 * 8, I7 = 32 * 8; constexpr int NITEMS = I0 + I6 + I7 + 64 + 16;
    unsigned char* ws = a.ws;
    for (int it = gw; it < NITEMS; it += NGW) {
        int r = it;
        if (r < I0) { tr_item(a.in[I_WIN], 5144, (bf16_t*)(ws + WS_WIN), 1024, scr, r / 168, r % 168, lane, 1); continue; } r -= I0;
        if (r < I6) { tr_item(a.in[I_W1K], 256, (bf16_t*)(ws + WS_WC1K), 2048, scr, r / 8, r % 8, lane, 0); continue; } r -= I6;
        if (r < I7) { tr_item(a.in[I_W1V], 256, (bf16_t*)(ws + WS_WC1V), 2048, scr, r / 8, r % 8, lane, 0); continue; } r -= I7;
        if (r >= 64) { const int q = r - 64;
            tr_item(a.in[q < 8 ? I_W2K : I_W2V], 64, (bf16_t*)(ws + WS_WC2T + (q < 8 ? 0 : 32768)), 256, scr, (q & 7) >> 1, q & 1, lane, 0); continue; }
        if (r < 16) tr_item(a.in[I_W2], 512, (bf16_t*)(ws + 38 * MiB), 64, scr, 0, r, lane, 0);
        else if (r < 32) tr_item(a.in[I_A2], 512, (bf16_t*)(ws + 38 * MiB + 65536), 64, scr, 0, r - 16, lane, 0);
        else tr_item(a.in[I_G2], 512, (bf16_t*)(ws + 38 * MiB + 131072), 128, scr, (r - 32) / 16, (r - 32) % 16, lane, 0);
    }
}
__device__ __forceinline__ void prologue_late_items(const Args& a, LAS float* scr, int gw, int NGW, int lane) {
    constexpr int I1 = 8 * 32, I2 = 8 * 32, I3 = 16 * 32, I4 = 16 * 176, I5 = 44 * 32; constexpr int NITEMS = I1 + I2 + I3 + I4 + I5;
    unsigned char* ws = a.ws;
    for (int it = gw; it < NITEMS; it += NGW) {
        int r = it;
        if (r < I1) { tr_item(a.in[I_WPA], 1024, (bf16_t*)(ws + WS_WPA), 512, scr, r / 32, r % 32, lane, 0); continue; } r -= I1;
        if (r < I2) { tr_item(a.in[I_WPB], 1024, (bf16_t*)(ws + WS_WPB), 512, scr, r / 32, r % 32, lane, 0); continue; } r -= I2;
        if (r < I3) { tr_item(a.in[I_WOUT], 1024, (bf16_t*)(ws + WS_WOUT), 1024, scr, r / 32, r % 32, lane, 0); continue; } r -= I3;
        if (r < I4) { tr_item(a.in[I_WUP], 5632, (bf16_t*)(ws + WS_WUP), 1024, scr, r / 176, r % 176, lane, 2, a.in[I_FNG]); continue; } r -= I4;
        tr_item(a.in[I_WDN], 1024, (bf16_t*)(ws + WS_WDN), 2816, scr, r / 32, r % 32, lane, 0);
    }
}
__device__ __forceinline__ void phase_prologue(const Args& a, LAS unsigned char* lds, int bid, int nb) {
    const int tid = threadIdx.x, lane = tid & 63, wave = tid >> 6;
    LAS float* scr = (LAS float*)(lds + wave * 16384);
    const int gw = bid * 8 + wave, NGW = nb * 8;
    prologue_early_items(a, scr, gw, NGW, lane);
    bf16_t* H = (bf16_t*)(a.ws + WS_H);
    for (int m = 4 * gw; m < NT; m += 4 * NGW) {
        rms_rows2_to_bf16(a.in[I_X] + (size_t)m * 1024, a.in[I_X] + (size_t)(m + 1) * 1024, a.in[I_ANG], H + (size_t)m * 1024, H + (size_t)(m + 1) * 1024, lane);
        rms_rows2_to_bf16(a.in[I_X] + (size_t)(m + 2) * 1024, a.in[I_X] + (size_t)(m + 3) * 1024, a.in[I_ANG], H + (size_t)(m + 2) * 1024, H + (size_t)(m + 3) * 1024, lane); }
}
__device__ __forceinline__ void gates_items(const Args& a, int gw, int NGW, int lane) {
    const int r32 = lane & 31, hi = lane >> 5;
    const bf16_t* H = (const bf16_t*)(a.ws + WS_H); const bf16_t* WG = (const bf16_t*)(a.ws + WS_WIN) + (size_t)(5120 + r32) * 1024 + 8 * hi; float* GT = (float*)(a.ws + WS_GT);
    for (int grp = gw; grp < NT / 32; grp += NGW) {
        const size_t m = (size_t)grp * 32 + r32; const bf16_t* hp = H + m * 1024 + 8 * hi;
        f32x16 acc = (f32x16){0.f, 0.f, 0.f, 0.f, 0.f, 0.f, 0.f, 0.f, 0.f, 0.f, 0.f, 0.f, 0.f, 0.f, 0.f, 0.f};
#pragma unroll 1
        for (int k8 = 0; k8 < 64; k8 += 8) {
            bf16x8 wa[8], hb[8];
#pragma unroll
            for (int q = 0; q < 8; ++q) { wa[q] = *(const bf16x8*)(WG + 16 * (k8 + q)); hb[q] = *(const bf16x8*)(hp + 16 * (k8 + q)); }
#pragma unroll
            for (int q = 0; q < 8; ++q) acc = __builtin_amdgcn_mfma_f32_32x32x16_bf16(wa[q], hb[q], acc, 0, 0, 0); }
#pragma unroll
        for (int q = 0; q < 3; ++q) *(f32x4*)(GT + m * 24 + 8 * q + 4 * hi) = (f32x4){sigmoidf_(acc[4 * q]), sigmoidf_(acc[4 * q + 1]), sigmoidf_(acc[4 * q + 2]), sigmoidf_(acc[4 * q + 3])};
    }
}
namespace att {
constexpr int SLOTB = 8192;
constexpr int L_BT = 0  , L_WS = 4096  , L_SEL = 6144  , L_FLG = 6656  , L_K = 8192, NSTG = 4  , L_V = L_K + NSTG * SLOTB, L_END = L_V + NSTG * SLOTB;
constexpr int C_K = 8192  , C_V = C_K + 4 * SLOTB, C_IMP = C_V + 4 * SLOTB  , IMPP = 260, C_END = C_IMP + 64 * IMPP * 4, C_BT = C_END  , C_GT = C_BT + 2048  , C_END2 = C_GT + 3072;
static_assert(C_END2 <= LDS_BYTES - 256, "cmp LDS");
__device__ __forceinline__ int crow(int r, int hi) { return (r & 3) + 8 * (r >> 2) + 4 * hi; }
__device__ __forceinline__ unsigned cvtpk(float lo, float hi) { typedef float f2_ __attribute__((ext_vector_type(2))); typedef __bf16 b2_ __attribute__((ext_vector_type(2))); const f2_ v = {lo, hi}; const b2_ b = __builtin_convertvector(v, b2_); return __builtin_bit_cast(unsigned, b); }
__device__ __forceinline__ void glds16(const void* gsrc, LAS unsigned char* dst) {
    __builtin_amdgcn_global_load_lds((const unsigned*)gsrc, (LAS unsigned*)dst, 16, 0, 0);
}
__device__ __forceinline__ void qkt(f32x16& p0, f32x16& p1, const LAS unsigned char* Kslot, const bf16x8* qr, int r32, int hi) {
    const LAS unsigned char* kb = Kslot + hi * 1024 + r32 * 16;
    p0 = (f32x16){0.f, 0.f, 0.f, 0.f, 0.f, 0.f, 0.f, 0.f, 0.f, 0.f, 0.f, 0.f, 0.f, 0.f, 0.f, 0.f}; p1 = p0;
    bf16x8 kf[4][2];
#pragma unroll
    for (int d0 = 0; d0 < 4; ++d0) { kf[d0][0] = *(const LAS bf16x8*)(kb + d0 * 2048); kf[d0][1] = *(const LAS bf16x8*)(kb + d0 * 2048 + 512); }
    __builtin_amdgcn_sched_barrier(0);
#pragma unroll
    for (int d0 = 0; d0 < 4; ++d0) {
        p0 = __builtin_amdgcn_mfma_f32_32x32x16_bf16(kf[d0][0], qr[d0], p0, 0, 0, 0);
        p1 = __builtin_amdgcn_mfma_f32_32x32x16_bf16(kf[d0][1], qr[d0], p1, 0, 0, 0);
    }
}
typedef short v4i16_t __attribute__((ext_vector_type(4)));
__device__ __forceinline__ s16x4 vtr(const LAS unsigned char* p) { return __builtin_bit_cast(s16x4, __builtin_amdgcn_ds_read_tr16_b64_v4i16((LAS v4i16_t*)p)); }
__device__ __forceinline__ void pv(f32x16* o, const LAS unsigned char* vp, bf16x8 pa0, bf16x8 pa1, bf16x8 pa2, bf16x8 pa3) {
    s16x4 lo[2][4], hi[2][4];
#pragma unroll
    for (int d0 = 0; d0 < 2; ++d0)
#pragma unroll
        for (int ks = 0; ks < 4; ++ks) { lo[d0][ks] = vtr(vp + d0 * 4096 + ks * 1024); hi[d0][ks] = vtr(vp + d0 * 4096 + ks * 1024 + 512); }
    __builtin_amdgcn_sched_barrier(0);
#define PK(d, k) (bf16x8){lo[d][k][0], lo[d][k][1], lo[d][k][2], lo[d][k][3], hi[d][k][0], hi[d][k][1], hi[d][k][2], hi[d][k][3]}
    o[0] = __builtin_amdgcn_mfma_f32_32x32x16_bf16(pa0, PK(0, 0), o[0], 0, 0, 0); o[1] = __builtin_amdgcn_mfma_f32_32x32x16_bf16(pa0, PK(1, 0), o[1], 0, 0, 0);
    o[0] = __builtin_amdgcn_mfma_f32_32x32x16_bf16(pa1, PK(0, 1), o[0], 0, 0, 0); o[1] = __builtin_amdgcn_mfma_f32_32x32x16_bf16(pa1, PK(1, 1), o[1], 0, 0, 0);
    o[0] = __builtin_amdgcn_mfma_f32_32x32x16_bf16(pa2, PK(0, 2), o[0], 0, 0, 0); o[1] = __builtin_amdgcn_mfma_f32_32x32x16_bf16(pa2, PK(1, 2), o[1], 0, 0, 0);
    o[0] = __builtin_amdgcn_mfma_f32_32x32x16_bf16(pa3, PK(0, 3), o[0], 0, 0, 0); o[1] = __builtin_amdgcn_mfma_f32_32x32x16_bf16(pa3, PK(1, 3), o[1], 0, 0, 0);
#undef PK
}
__device__ __forceinline__ void qkt_c(f32x16& p0, f32x16& p1, const LAS unsigned char* Kslot, const bf16x8* qr, const f32x16& cin, int r32, int hi) {
    const LAS unsigned char* kb = Kslot + hi * 1024 + r32 * 16;
#pragma unroll
    for (int d0 = 0; d0 < 4; ++d0) {
        const bf16x8 b0 = *(const LAS bf16x8*)(kb + d0 * 2048);
        const bf16x8 b1 = *(const LAS bf16x8*)(kb + d0 * 2048 + 512);
        if (d0 == 0) { p0 = __builtin_amdgcn_mfma_f32_32x32x16_bf16(b0, qr[0], cin, 0, 0, 0); p1 = __builtin_amdgcn_mfma_f32_32x32x16_bf16(b1, qr[0], cin, 0, 0, 0); }
        else { p0 = __builtin_amdgcn_mfma_f32_32x32x16_bf16(b0, qr[d0], p0, 0, 0, 0); p1 = __builtin_amdgcn_mfma_f32_32x32x16_bf16(b1, qr[d0], p1, 0, 0, 0); }
    }
}
__device__ __forceinline__ void qkt_acc(f32x16& p0, f32x16& p1, const LAS unsigned char* Kslot, const bf16x8* qr, int r32, int hi) {
    const LAS unsigned char* kb = Kslot + hi * 1024 + r32 * 16;
    bf16x8 kf[4][2];
#pragma unroll
    for (int d0 = 0; d0 < 4; ++d0) { kf[d0][0] = *(const LAS bf16x8*)(kb + d0 * 2048); kf[d0][1] = *(const LAS bf16x8*)(kb + d0 * 2048 + 512); }
    __builtin_amdgcn_sched_barrier(0);
#pragma unroll
    for (int d0 = 0; d0 < 4; ++d0) {
        p0 = __builtin_amdgcn_mfma_f32_32x32x16_bf16(kf[d0][0], qr[d0], p0, 0, 0, 0);
        p1 = __builtin_amdgcn_mfma_f32_32x32x16_bf16(kf[d0][1], qr[d0], p1, 0, 0, 0);
    }
}
template <int MODE>
__device__ __forceinline__ void branch(f32x16 (&o)[2], LAS unsigned char* shm, const bf16x8 (&qr)[4], const bf16_t* Kg  , const bf16_t* Vg  ,
                                       int qb, unsigned long long sel, float bfar  , int wid, int lane) {
    const int r32 = lane & 31, hi = lane >> 5, th = wid & 1, hr = wid >> 1;
    const int tq = 32 * th + r32;
    const int j0 = MODE == 0 ? 0 : (qb >= 8 ? qb - 8 : 0), nt = qb - j0 + 1;
    LAS float* wsf = (LAS float*)(shm + L_WS) + wid * 64;
    const LAS float* bt = (const LAS float*)(shm + L_BT) + hr * 256;
    const bf16_t* ksrc = Kg + (size_t)lane * 128 + wid * 8;
    const bf16_t* vsrc = Vg + (size_t)(16 * (wid & 3) + (lane >> 2)) * 128 + (wid >> 2) * 32 + (lane & 3) * 8;
    const LAS unsigned char* vp0 = shm + L_V + ((lane >> 4) & 1) * 32 + (lane & 3) * 8 + (4 * hi + ((lane & 15) >> 2)) * 64;
    o[0] = (f32x16){0.f, 0.f, 0.f, 0.f, 0.f, 0.f, 0.f, 0.f, 0.f, 0.f, 0.f, 0.f, 0.f, 0.f, 0.f, 0.f}; o[1] = o[0];
    float M = 0.f, lsum = 0.f;
    bool scaled = false;
#define DMA_TILE(ii) do { const int s_ = ((ii) & (NSTG - 1)) * SLOTB; glds16(ksrc + (size_t)(64 * (j0 + (ii))) * 128, shm + L_K + s_ + wid * 1024); glds16(vsrc + (size_t)(64 * (j0 + (ii))) * 128, shm + L_V + s_ + wid * 1024); } while (0)
#define SCORE(P0, P1, ii) qkt(P0, P1, shm + L_K + ((ii) & (NSTG - 1)) * SLOTB, qr, r32, hi)
#define FINISH(P0, P1, ii) do { const int j = j0 + (ii), dq = qb - j; const bool far = dq >= 3; \
        bool rowsel = true; if (MODE == 0) rowsel = (sel >> j) & 1ull; \
        if (!far) { \
            if (!scaled) { const float fb = __builtin_amdgcn_exp2f(bfar); lsum *= fb; _Pragma("unroll") for (int r = 0; r < 16; ++r) { o[0][r] *= fb; o[1][r] *= fb; } scaled = true; } \
        } else if (MODE == 1 && dq == 8) {                             \
            _Pragma("unroll") for (int r = 0; r < 16; ++r) { const int d0 = 512 + tq - crow(r, hi), d1 = d0 - 32; P0[r] = d0 < 512 ? P0[r] : -INFINITY; P1[r] = d1 < 512 ? P1[r] : -INFINITY; } } \
        if (__any(M != 0.f)) { _Pragma("unroll") for (int r = 0; r < 16; ++r) { P0[r] -= M; P1[r] -= M; } }     \
        float sm = 0.f; \
        _Pragma("unroll") for (int r = 0; r < 16; ++r) { P0[r] = __builtin_amdgcn_exp2f(P0[r]); P1[r] = __builtin_amdgcn_exp2f(P1[r]); sm += P0[r] + P1[r]; } \
        u32x4 pw0, pw1, pw2, pw3; \
        pw0 = (u32x4){cvtpk(P0[0], P0[1]), cvtpk(P0[2], P0[3]), cvtpk(P0[4], P0[5]), cvtpk(P0[6], P0[7])}; \
        pw1 = (u32x4){cvtpk(P0[8], P0[9]), cvtpk(P0[10], P0[11]), cvtpk(P0[12], P0[13]), cvtpk(P0[14], P0[15])}; \
        pw2 = (u32x4){cvtpk(P1[0], P1[1]), cvtpk(P1[2], P1[3]), cvtpk(P1[4], P1[5]), cvtpk(P1[6], P1[7])}; \
        pw3 = (u32x4){cvtpk(P1[8], P1[9]), cvtpk(P1[10], P1[11]), cvtpk(P1[12], P1[13]), cvtpk(P1[14], P1[15])}; \
        if (MODE == 0 && !__all(rowsel)) { const unsigned mk = rowsel ? 0xffffffffu : 0u; pw0 &= mk; pw1 &= mk; pw2 &= mk; pw3 &= mk; sm = rowsel ? sm : 0.f; } \
        lsum += sm; \
        pv(o, vp0 + ((ii) & (NSTG - 1)) * SLOTB, __builtin_bit_cast(bf16x8, pw0), __builtin_bit_cast(bf16x8, pw1), __builtin_bit_cast(bf16x8, pw2), __builtin_bit_cast(bf16x8, pw3)); \
        if (__any(sm > 1.0e12f)) {                                     \
            float big = fmaxf(sm, __shfl_xor(sm, 32)); const float dl = big > 1.0f ? floorf(__builtin_amdgcn_logf(big)) : 0.f; const float f = __builtin_amdgcn_exp2f(-dl); M += dl; \
            lsum *= f; if (hi == 0) wsf[r32] = f; LDS_WAIT(); asm volatile("" ::: "memory"); \
            _Pragma("unroll") for (int r = 0; r < 16; ++r) { const float fr = wsf[crow(r, hi)]; o[0][r] *= fr; o[1][r] *= fr; } \
            LDS_WAIT(); asm volatile("" ::: "memory"); } } while (0)
    DMA_TILE(0); if (nt > 1) DMA_TILE(1); if (nt > 2) DMA_TILE(2);
    for (int i = 0; i < nt; ++i) {
        { const int rem = nt - 1 - i; if (rem >= 2) asm volatile("s_waitcnt vmcnt(4)" ::: "memory"); else if (rem == 1) asm volatile("s_waitcnt vmcnt(2)" ::: "memory"); else asm volatile("s_waitcnt vmcnt(0)" ::: "memory"); }
        __builtin_amdgcn_s_barrier(); asm volatile("" ::: "memory");
        if (i + 3 < nt) DMA_TILE(i + 3);
        f32x16 p0, p1;
        if (qb - (j0 + i) < 3) {
            const LAS float* bl = bt + (191 - 64 * (qb - (j0 + i)) - tq + 4 * hi);
#pragma unroll
            for (int r = 0; r < 16; ++r) { p0[r] = bl[(r & 3) + 8 * (r >> 2)]; p1[r] = bl[32 + (r & 3) + 8 * (r >> 2)]; }
            qkt_acc(p0, p1, shm + L_K + (i & (NSTG - 1)) * SLOTB, qr, r32, hi);
        } else SCORE(p0, p1, i);
        FINISH(p0, p1, i);
    }
#undef STEP
#undef FINISH
#undef SCORE
#undef DMA_TILE
    lsum += __shfl_xor(lsum, 32);
    if (hi == 0) wsf[32 + r32] = lsum;
    LDS_WAIT(); asm volatile("" ::: "memory");
#pragma unroll
    for (int r = 0; r < 16; ++r) { const float li = __builtin_amdgcn_rcpf(fmaxf(wsf[32 + crow(r, hi)], 1e-30f)); o[0][r] *= li; o[1][r] *= li; }
    LDS_WAIT(); asm volatile("" ::: "memory");
    __syncthreads();
}
__device__ __forceinline__ void cmp_branch(f32x16 (&o)[2], LAS unsigned char* shm, const bf16x8 (&qr)[4], const bf16_t* Kg, const bf16_t* Vg, int qb, float bfar, int wid, int lane) {
    const int r32 = lane & 31, hi = lane >> 5, th = wid & 1, hr = wid >> 1, tid = threadIdx.x;
    const int tq = 32 * th + r32;
    const int nkt = (4 * qb + 3 + 63) >> 6;
    LAS float* wsf = (LAS float*)(shm + L_WS) + wid * 64;
    const LAS float* bt = (const LAS float*)(shm + L_BT) + hr * 256;
    LAS unsigned* imp = (LAS unsigned*)(shm + C_IMP);
    const LAS float* btc = (const LAS float*)(shm + C_BT) + hr * 128 + 1;
    const bf16_t* ksrc = Kg + (size_t)lane * 64 + wid * 8;
    const bf16_t* vsrc = Vg + (size_t)(16 * (wid & 3) + (lane >> 2)) * 64 + (wid >> 2) * 32 + (lane & 3) * 8;
    const LAS unsigned char* vp0 = shm + C_V + ((lane >> 4) & 1) * 32 + (lane & 3) * 8 + (4 * hi + ((lane & 15) >> 2)) * 64;
    for (int kt = 0; kt < nkt; ++kt) { glds16(ksrc + (size_t)(64 * kt) * 64, shm + C_K + kt * SLOTB + wid * 1024); glds16(vsrc + (size_t)(64 * kt) * 64, shm + C_V + kt * SLOTB + wid * 1024); }
    for (int e = tid; e < 64 * IMPP; e += 512) imp[e] = 0u;
    o[0] = (f32x16){0.f, 0.f, 0.f, 0.f, 0.f, 0.f, 0.f, 0.f, 0.f, 0.f, 0.f, 0.f, 0.f, 0.f, 0.f, 0.f}; o[1] = o[0];
    VM_WAIT(); __syncthreads();
    float mrun = -1e30f, lrun = 0.f;
#define CMP_SCORES(kt) \
        f32x16 p0, p1; \
        if (64 * qb - 31 - 1024 * (kt) - 1008 >= 113) qkt(p0, p1, shm + C_K + (kt) * SLOTB, qr, r32, hi);     \
        else { const int dl = 64 * qb + tq - 31 - 1024 * (kt) - 64 * hi; \
            _Pragma("unroll") for (int r = 0; r < 16; ++r) { const int d0 = dl - 16 * ((r & 3) + 8 * (r >> 2)), d1 = d0 - 512; \
                p0[r] = btc[min(max(d0, -1), 113)]; p1[r] = btc[min(max(d1, -1), 113)]; } \
            qkt_acc(p0, p1, shm + C_K + (kt) * SLOTB, qr, r32, hi); }
    for (int kt = 0; kt < nkt; ++kt) {
        CMP_SCORES(kt)
        float sm = 0.f;
#pragma unroll
        for (int r = 0; r < 16; ++r) sm += __builtin_amdgcn_exp2f(p0[r]) + __builtin_amdgcn_exp2f(p1[r]);
        lrun += sm;
    }
    lrun += __shfl_xor(lrun, 32); mrun = 0.f;
    if (__any(!(lrun < 1.0e30f) || (lrun < 1.0e-30f && 64 * qb + tq >= 31))) {
    mrun = -1e30f; lrun = 0.f;
    for (int kt = 0; kt < nkt; ++kt) {
        CMP_SCORES(kt)
        float mx = mrun;
#pragma unroll
        for (int r = 0; r < 16; ++r) mx = fmaxf(mx, fmaxf(p0[r], p1[r]));
        mx = fmaxf(mx, __shfl_xor(mx, 32));
        float sm = 0.f;
#pragma unroll
        for (int r = 0; r < 16; ++r) sm += __builtin_amdgcn_exp2f(p0[r] - mx) + __builtin_amdgcn_exp2f(p1[r] - mx);
        sm += __shfl_xor(sm, 32);
        lrun = lrun * __builtin_amdgcn_exp2f(mrun - mx) + sm; mrun = mx;
    }
    }
    const float invl = 1.0f / fmaxf(lrun, 1e-30f), invf = invl * 67108864.0f;
    const bool shifted = __any(mrun != 0.f);
    for (int kt = 0; kt < nkt; ++kt) {
        CMP_SCORES(kt)
#pragma unroll
        for (int r = 0; r < 16; ++r) { p0[r] = __builtin_amdgcn_exp2f(shifted ? p0[r] - mrun : p0[r]); p1[r] = __builtin_amdgcn_exp2f(shifted ? p1[r] - mrun : p1[r]); }
        LAS unsigned* ir = imp + tq * IMPP + 64 * kt;
#pragma unroll
        for (int r = 0; r < 16; ++r) { __hip_atomic_fetch_add(ir + crow(r, hi), (unsigned)(p0[r] * invf + 0.5f), __ATOMIC_RELAXED, __HIP_MEMORY_SCOPE_WORKGROUP); __hip_atomic_fetch_add(ir + 32 + crow(r, hi), (unsigned)(p1[r] * invf + 0.5f), __ATOMIC_RELAXED, __HIP_MEMORY_SCOPE_WORKGROUP); }
        u32x4 pw0, pw1, pw2, pw3;
        pw0 = (u32x4){cvtpk(p0[0], p0[1]), cvtpk(p0[2], p0[3]), cvtpk(p0[4], p0[5]), cvtpk(p0[6], p0[7])};
        pw1 = (u32x4){cvtpk(p0[8], p0[9]), cvtpk(p0[10], p0[11]), cvtpk(p0[12], p0[13]), cvtpk(p0[14], p0[15])};
        pw2 = (u32x4){cvtpk(p1[0], p1[1]), cvtpk(p1[2], p1[3]), cvtpk(p1[4], p1[5]), cvtpk(p1[6], p1[7])};
        pw3 = (u32x4){cvtpk(p1[8], p1[9]), cvtpk(p1[10], p1[11]), cvtpk(p1[12], p1[13]), cvtpk(p1[14], p1[15])};
        pv(o, vp0 + kt * SLOTB, __builtin_bit_cast(bf16x8, pw0), __builtin_bit_cast(bf16x8, pw1), __builtin_bit_cast(bf16x8, pw2), __builtin_bit_cast(bf16x8, pw3));
    }
#undef CMP_SCORES
    if (hi == 0) wsf[r32] = invl;
    LDS_WAIT(); asm volatile("" ::: "memory");
#pragma unroll
    for (int r = 0; r < 16; ++r) { const float li = wsf[crow(r, hi)]; o[0][r] *= li; o[1][r] *= li; }
    LDS_WAIT(); asm volatile("" ::: "memory");
    __syncthreads();
    {   const int j = lane, cur = qb;
        const bool forced = (j == 0) || (j == cur) || (j == cur - 1), valid = j <= cur;
#pragma unroll 1
        for (int u = 0; u < 8; u += 4) {
            unsigned key[4], T[4];
#pragma unroll
            for (int v = 0; v < 4; ++v) { const LAS unsigned* ip = imp + (8 * wid + u + v) * IMPP + 4 * j;
                const unsigned sc0 = (j > 0 ? ip[-1] : 0u) + 2u * ip[0] + 2u * ip[1] + 2u * ip[2] + ip[3];
                key[v] = valid ? (forced ? 0xffffffffu : sc0 + 1u) : 0u; T[v] = 0u; }
#define BIS_STEP(BM) do { unsigned c0, c1, c2, c3, n0, n1, n2, n3; unsigned long long m0, m1, m2, m3; \
                asm volatile("s_or_b32 %[c0], %[t0], %[bm]\n\ts_or_b32 %[c1], %[t1], %[bm]\n\ts_or_b32 %[c2], %[t2], %[bm]\n\ts_or_b32 %[c3], %[t3], %[bm]\n\t" \
                             "v_cmp_le_u32_e64 %[m0], %[c0], %[k0]\n\tv_cmp_le_u32_e64 %[m1], %[c1], %[k1]\n\tv_cmp_le_u32_e64 %[m2], %[c2], %[k2]\n\tv_cmp_le_u32_e64 %[m3], %[c3], %[k3]\n\t" \
                             "s_bcnt1_i32_b64 %[n0], %[m0]\n\ts_bcnt1_i32_b64 %[n1], %[m1]\n\ts_bcnt1_i32_b64 %[n2], %[m2]\n\ts_bcnt1_i32_b64 %[n3], %[m3]\n\t" \
                             "s_cmp_ge_u32 %[n0], 16\n\ts_cselect_b32 %[t0], %[c0], %[t0]\n\ts_cmp_ge_u32 %[n1], 16\n\ts_cselect_b32 %[t1], %[c1], %[t1]\n\t" \
                             "s_cmp_ge_u32 %[n2], 16\n\ts_cselect_b32 %[t2], %[c2], %[t2]\n\ts_cmp_ge_u32 %[n3], 16\n\ts_cselect_b32 %[t3], %[c3], %[t3]" \
                             : [t0] "+s"(T[0]), [t1] "+s"(T[1]), [t2] "+s"(T[2]), [t3] "+s"(T[3]), [c0] "=&s"(c0), [c1] "=&s"(c1), [c2] "=&s"(c2), [c3] "=&s"(c3), \
                               [m0] "=&s"(m0), [m1] "=&s"(m1), [m2] "=&s"(m2), [m3] "=&s"(m3), [n0] "=&s"(n0), [n1] "=&s"(n1), [n2] "=&s"(n2), [n3] "=&s"(n3) \
                             : [k0] "v"(key[0]), [k1] "v"(key[1]), [k2] "v"(key[2]), [k3] "v"(key[3]), [bm] "n"(BM) : "scc"); } while (0)
#define BIS_4(B3) do { BIS_STEP(1u << (B3)); BIS_STEP(1u << ((B3) - 1)); BIS_STEP(1u << ((B3) - 2)); BIS_STEP(1u << ((B3) - 3)); } while (0)
#define BIS_FIN() (__builtin_popcountll(__ballot(key[0] >= T[0])) == 16 && __builtin_popcountll(__ballot(key[1] >= T[1])) == 16 && __builtin_popcountll(__ballot(key[2] >= T[2])) == 16 && __builtin_popcountll(__ballot(key[3] >= T[3])) == 16)
            do { BIS_4(31); if (BIS_FIN()) break; BIS_4(27); if (BIS_FIN()) break; BIS_4(23); if (BIS_FIN()) break; BIS_4(19); if (BIS_FIN()) break;
                 BIS_4(15); if (BIS_FIN()) break; BIS_4(11); if (BIS_FIN()) break; BIS_4(7); if (BIS_FIN()) break; BIS_4(3); } while (0);
#undef BIS_FIN
#undef BIS_4
#undef BIS_STEP
#pragma unroll
            for (int v = 0; v < 4; ++v) {
                const unsigned long long gtm = __ballot(key[v] > T[v]), eqm = __ballot(key[v] == T[v]);
                const int need = 16 - (int)__builtin_popcountll(gtm);
                const int eqrank = (int)__builtin_amdgcn_mbcnt_hi((unsigned)(eqm >> 32), __builtin_amdgcn_mbcnt_lo((unsigned)eqm, 0u));
                const unsigned long long msk = __ballot(valid && (key[v] > T[v] || (key[v] == T[v] && eqrank < need)));
                if (lane == 0) ((LAS unsigned long long*)(shm + L_SEL))[8 * wid + u + v] = msk; } }
    }
    LDS_WAIT(); asm volatile("" ::: "memory");
    __syncthreads();
}
}

__device__ __forceinline__ void phase_attn(const Args& a, LAS unsigned char* lds, int bid, int nb) {
    using namespace att;
    const int tid = threadIdx.x, lane = tid & 63, wid = __builtin_amdgcn_readfirstlane(tid >> 6);
    const int r32 = lane & 31, hi = lane >> 5, th = wid & 1, hr = wid >> 1;
    const bf16_t* Q = (const bf16_t*)(a.ws + WS_Q); const bf16_t* VSN = (const bf16_t*)(a.ws + WS_VSN); const bf16_t* VWN = (const bf16_t*)(a.ws + WS_VWN);
    const bf16_t* KSN = (const bf16_t*)(a.ws + WS_KSN); const bf16_t* KWN = (const bf16_t*)(a.ws + WS_KWN);
    const bf16_t* KCB = (const bf16_t*)(a.ws + WS_KCB); const bf16_t* VCB = (const bf16_t*)(a.ws + WS_VCB); bf16_t* OA = (bf16_t*)(a.ws + WS_OA);
    const float* GT = (const float*)(a.ws + WS_GT);
    const float* relb = a.in[I_RELB];
    LAS unsigned char* shm = lds;
    for (int it = bid; it < 1024; it += nb) {
        const int c = it & 255, k = it >> 8, x = c >> 4, bg = c & 15;
        const int qb = (k == 0) ? 63 - x : (k == 1) ? 32 + x : (k == 2) ? 31 - x : x;
        const int b = bg >> 1, g = bg & 1, h = g * 4 + hr;
        for (int e = tid; e < 1024; e += 512) { const int hh = e >> 8, d = 191 - (e & 255); ((LAS float*)(shm + L_BT))[e] = d < 0 ? -INFINITY : relb[t5_bucket(d) * 8 + g * 4 + hh] * LOG2E; }
        const float bfar = relb[31 * 8 + h] * LOG2E;
        __syncthreads();
        for (int e = tid; e < 768; e += 512) { const int tk = e / 12, c12 = e % 12; ((LAS float*)(shm + C_GT))[e] = GT[((size_t)b * SEQ + 64 * qb + tk) * 24 + g * 12 + c12]; }
        { const int hh = tid >> 7, e = tid & 127, d = e - 1; ((LAS float*)(shm + C_BT))[tid] = d < 0 ? -INFINITY : (relb[t5_bucket(min(d, 113)) * 8 + g * 4 + hh] - relb[31 * 8 + g * 4 + hh]) * LOG2E; }
        const int t = 64 * qb + 32 * th + r32; const size_t m = (size_t)b * SEQ + t;
        bf16x8 qr[4];
#pragma unroll
        for (int d0 = 0; d0 < 4; ++d0) qr[d0] = *(const bf16x8*)(Q + m * 512 + h * 64 + hi * 8 + d0 * 16);
        __syncthreads();
        f32x16 acc[2];
#define GATE_ACC(O, K, FIRST) do { const LAS float* gp_ = (const LAS float*)(shm + C_GT) + (32 * th + 4 * hi) * 12 + hr * 3 + (K); \
            _Pragma("unroll") for (int r = 0; r < 16; ++r) { const float gk = gp_[((r & 3) + 8 * (r >> 2)) * 12]; \
            if (FIRST) { acc[0][r] = gk * O[0][r]; acc[1][r] = gk * O[1][r]; } else { acc[0][r] += gk * O[0][r]; acc[1][r] += gk * O[1][r]; } } } while (0)
        LAS float* park = (LAS float*)(shm + C_IMP) + wid * 2048 + lane;
        { f32x16 oc[2]; cmp_branch(oc, shm, qr, KCB + (size_t)bg * 256 * 64, VCB + (size_t)bg * 256 * 64, qb, bfar, wid, lane); GATE_ACC(oc, 0, true);
#pragma unroll
          for (int r = 0; r < 16; ++r) { park[r * 64] = acc[0][r]; park[(16 + r) * 64] = acc[1][r]; } }
        const unsigned long long sel = ((const LAS unsigned long long*)(shm + L_SEL))[32 * th + r32];
        { f32x16 os[2]; branch<0>(os, shm, qr, KSN + (size_t)b * SEQ * 128 + g * 64, VSN + (size_t)b * SEQ * 128 + g * 64, qb, sel, bfar, wid, lane);
#pragma unroll
          for (int r = 0; r < 16; ++r) { acc[0][r] = park[r * 64]; acc[1][r] = park[(16 + r) * 64]; }
          GATE_ACC(os, 1, false);
#pragma unroll
          for (int r = 0; r < 16; ++r) { park[r * 64] = acc[0][r]; park[(16 + r) * 64] = acc[1][r]; } }
        { f32x16 ow[2]; branch<1>(ow, shm, qr, KWN + (size_t)b * SEQ * 128 + g * 64, VWN + (size_t)b * SEQ * 128 + g * 64, qb, sel, bfar, wid, lane);
#pragma unroll
          for (int r = 0; r < 16; ++r) { acc[0][r] = park[r * 64]; acc[1][r] = park[(16 + r) * 64]; }
          GATE_ACC(ow, 2, false); }
#undef GATE_ACC
#pragma unroll
        for (int r = 0; r < 16; ++r) { const size_t mm = (size_t)b * SEQ + 64 * qb + 32 * th + crow(r, hi);
#pragma unroll
            for (int d0 = 0; d0 < 2; ++d0) OA[mm * 512 + h * 64 + 32 * d0 + r32] = (bf16_t)(cvtpk(acc[d0][r], 0.f) & 0xffffu); }
    }
}
namespace rk {
constexpr int PITCH = 144;
constexpr int SLOT = 64 * PITCH;
constexpr size_t RS_MP = 40 * MiB, RS_NN = 72 * MiB, RS_RH = 104 * MiB, RS_Y0 = 136 * MiB, RS_GCB = 168 * MiB;
constexpr size_t WS_W2T = 38 * MiB, WS_A2T = WS_W2T + 65536, WS_G2T = WS_A2T + 65536;
__device__ __forceinline__ int crow(int r, int hi) { return (r & 3) + 8 * (r >> 2) + 4 * hi; }
__device__ __forceinline__ unsigned cvtpk(float lo, float hi) { typedef float f2_ __attribute__((ext_vector_type(2))); typedef __bf16 b2_ __attribute__((ext_vector_type(2))); const f2_ v = {lo, hi}; const b2_ b = __builtin_convertvector(v, b2_); return __builtin_bit_cast(unsigned, b); }
__device__ __forceinline__ float fexp(float x) { return __builtin_amdgcn_exp2f(x * 1.4426950408889634f); }
__device__ __forceinline__ float ftanh(float x) { const float e = __builtin_amdgcn_exp2f(x * 2.8853900817779268f); return 1.0f - 2.0f * __builtin_amdgcn_rcpf(e + 1.0f); }
__device__ __forceinline__ float fsoftplus(float x) { return x > 20.f ? x : 0.6931471805599453f * __builtin_amdgcn_logf(1.0f + __builtin_amdgcn_exp2f(x * 1.4426950408889634f)); }
__device__ __forceinline__ float fsigm(float x) { return __builtin_amdgcn_rcpf(1.0f + __builtin_amdgcn_exp2f(-x * 1.4426950408889634f)); }
__device__ __forceinline__ unsigned cvt1(float x) { return cvtpk(x, 0.f) & 0xffffu; }
__device__ __forceinline__ f32x16 zero16() { return (f32x16){0.f, 0.f, 0.f, 0.f, 0.f, 0.f, 0.f, 0.f, 0.f, 0.f, 0.f, 0.f, 0.f, 0.f, 0.f, 0.f}; }
__device__ __forceinline__ void tile_nt(f32x16& acc, const LAS unsigned char* XA, int ta, const LAS unsigned char* YB, int tb, int r32, int hi) {
    const LAS unsigned char* pa = XA + (32 * ta + r32) * PITCH + 16 * hi; const LAS unsigned char* pb = YB + (32 * tb + r32) * PITCH + 16 * hi;
    bf16x8 fa[4], fb[4];
#pragma unroll
    for (int ks = 0; ks < 4; ++ks) { fa[ks] = *(const LAS bf16x8*)(pa + 32 * ks); fb[ks] = *(const LAS bf16x8*)(pb + 32 * ks); }
    __builtin_amdgcn_sched_barrier(0);
#pragma unroll
    for (int ks = 0; ks < 4; ++ks) acc = __builtin_amdgcn_mfma_f32_32x32x16_bf16(fa[ks], fb[ks], acc, 0, 0, 0);
}
__device__ __forceinline__ void wr_t(LAS unsigned char* D, const f32x16& acc, int ta, int tb, int r32, int hi) {
#pragma unroll
    for (int q = 0; q < 4; ++q) { u32x2 w; w.x = cvtpk(acc[4 * q], acc[4 * q + 1]); w.y = cvtpk(acc[4 * q + 2], acc[4 * q + 3]);
        *(LAS u32x2*)(D + (32 * tb + r32) * PITCH + (32 * ta + 8 * q + 4 * hi) * 2) = w; }
}
__device__ __forceinline__ void wr_d(LAS unsigned char* D, const f32x16& acc, int ta, int tb, int r32, int hi) {
#pragma unroll
    for (int r = 0; r < 16; ++r) *(LAS bf16_t*)(D + (32 * ta + crow(r, hi)) * PITCH + (32 * tb + r32) * 2) = (bf16_t)cvt1(acc[r]);
}
}

__device__ __forceinline__ void rwkv_pass1(const Args& a, LAS unsigned char* lds, int bid, int nb) {
    using namespace rk;
    const int tid = threadIdx.x, lane = tid & 63, wid = __builtin_amdgcn_readfirstlane(tid >> 6), r32 = lane & 31, hi = lane >> 5;
    const bf16_t* RW = (const bf16_t*)(a.ws + WS_RW); const float* mu = a.in[I_MU];
    const bf16_t* W2T = (const bf16_t*)(a.ws + WS_W2T); const bf16_t* A2T = (const bf16_t*)(a.ws + WS_A2T);
#define SL(k) (lds + (k) * SLOT)
    LAS float* WP = (LAS float*)(lds + 8 * SLOT);
    LAS float* AP = (LAS float*)(lds + 8 * SLOT + 17408);
    LAS float* CL = (LAS float*)(lds + 8 * SLOT + 2 * 17408);
    LAS float* SEG = CL + 64 * 68; LAS float* CLAST = SEG + 8 * 68;
    const int tj = tid >> 3, jb = (tid & 7) * 8;
    const int tile = wid & 3, ta = tile >> 1, tb = tile & 1, grp = wid >> 2;
#define LBAR() do { asm volatile("s_waitcnt lgkmcnt(0)" ::: "memory"); __builtin_amdgcn_s_barrier(); asm volatile("" ::: "memory"); } while (0)
    u32x4 fa0, fa1, fb0, fb1, fr0, fr1, fk0, fk1, fv0, fv1;
#define LOAD_RAW(itx) do { const int c_ = (itx) & 63, h_ = ((itx) >> 6) & 7, b_ = (itx) >> 9; const size_t mr_ = (size_t)b_ * SEQ + 64 * c_ + (tid >> 3); const bool hp_ = (64 * c_ + (tid >> 3)) > 0; \
        const bf16_t* r1_ = RW + mr_ * 1792 + 1536 + (tid & 7) * 16; const bf16_t* r3_ = RW + mr_ * 1792 + h_ * 64 + (tid & 7) * 8; const u32x4 z_ = (u32x4){0u, 0u, 0u, 0u}; \
        fa0 = *(const u32x4*)r1_; fa1 = *(const u32x4*)(r1_ + 8); fb0 = hp_ ? *(const u32x4*)(r1_ - 1792) : z_; fb1 = hp_ ? *(const u32x4*)(r1_ - 1792 + 8) : z_; \
        fr0 = *(const u32x4*)r3_; fk0 = *(const u32x4*)(r3_ + 512); fv0 = *(const u32x4*)(r3_ + 1024); \
        fr1 = hp_ ? *(const u32x4*)(r3_ - 1792) : z_; fk1 = hp_ ? *(const u32x4*)(r3_ - 1792 + 512) : z_; fv1 = hp_ ? *(const u32x4*)(r3_ - 1792 + 1024) : z_; } while (0)
    const f32x4 m0_ = *(const f32x4*)(mu + 1536 + (tid & 7) * 16), m1_ = *(const f32x4*)(mu + 1536 + (tid & 7) * 16 + 4), m2_ = *(const f32x4*)(mu + 1536 + (tid & 7) * 16 + 8), m3_ = *(const f32x4*)(mu + 1536 + (tid & 7) * 16 + 12);
    if (bid < 4096) LOAD_RAW(bid);
    for (int it = bid; it < 4096; it += nb) {
        const int c = it & 63, h = (it >> 6) & 7, b = it >> 9; const int t0 = 64 * c; const size_t m0 = (size_t)b * SEQ + t0;
        {   const int t = tid >> 3, c0 = (tid & 7) * 16; const int col = 1536 + c0; const size_t m = m0 + t;
            const u32x4 p0 = fa0, p1 = fa1, s0 = fb0, s1 = fb1; (void)m;
            float x[16]; const unsigned pw[8] = {p0.x, p0.y, p0.z, p0.w, p1.x, p1.y, p1.z, p1.w}, sw[8] = {s0.x, s0.y, s0.z, s0.w, s1.x, s1.y, s1.z, s1.w};
            const float mv[16] = {m0_.x, m0_.y, m0_.z, m0_.w, m1_.x, m1_.y, m1_.z, m1_.w, m2_.x, m2_.y, m2_.z, m2_.w, m3_.x, m3_.y, m3_.z, m3_.w};
#pragma unroll
            for (int e = 0; e < 8; ++e) { const float pl_ = bflo(pw[e]), ph_ = bfhi(pw[e]); x[2 * e] = pl_ + (bflo(sw[e]) - pl_) * mv[2 * e]; x[2 * e + 1] = ph_ + (bfhi(sw[e]) - ph_) * mv[2 * e + 1]; }
            if (c0 < 64) {
#pragma unroll
                for (int e = 0; e < 16; ++e) x[e] = ftanh(x[e]); }
            LAS unsigned char* dst = (c0 < 64 ? SL(14) : SL(15)) + t * PITCH + (c0 & 63) * 2;
            *(LAS u32x4*)dst = (u32x4){cvtpk(x[0], x[1]), cvtpk(x[2], x[3]), cvtpk(x[4], x[5]), cvtpk(x[6], x[7])};
            *(LAS u32x4*)(dst + 16) = (u32x4){cvtpk(x[8], x[9]), cvtpk(x[10], x[11]), cvtpk(x[12], x[13]), cvtpk(x[14], x[15])};
        }
        bf16x8 wf[4];
        {   const bf16_t* WT = (grp == 0 ? W2T : A2T) + (size_t)(h * 64 + 32 * ta + r32) * 64 + 8 * hi;
#pragma unroll
            for (int ks = 0; ks < 4; ++ks) wf[ks] = *(const bf16x8*)(WT + 16 * ks); }
        LBAR();
        {   const LAS unsigned char* pb = (grp == 0 ? SL(14) : SL(15)) + (32 * tb + r32) * PITCH + 16 * hi;
            f32x16 acc = zero16(); bf16x8 xf_[4];
#pragma unroll
            for (int ks = 0; ks < 4; ++ks) xf_[ks] = *(const LAS bf16x8*)(pb + 32 * ks);
            __builtin_amdgcn_sched_barrier(0);
#pragma unroll
            for (int ks = 0; ks < 4; ++ks) acc = __builtin_amdgcn_mfma_f32_32x32x16_bf16(wf[ks], xf_[ks], acc, 0, 0, 0);
            LAS float* D = grp == 0 ? WP : AP;
#pragma unroll
            for (int q = 0; q < 4; ++q) *(LAS f32x4*)(D + (32 * tb + r32) * 68 + 32 * ta + 8 * q + 4 * hi) = (f32x4){acc[4 * q], acc[4 * q + 1], acc[4 * q + 2], acc[4 * q + 3]};
        }
        f32x4 pq[16];
        {   const int hj = h * 64 + jb;
#pragma unroll
            for (int q = 0; q < 3; ++q) { pq[2 * q] = *(const f32x4*)(mu + q * 512 + hj); pq[2 * q + 1] = *(const f32x4*)(mu + q * 512 + hj + 4); }
            pq[6] = *(const f32x4*)(a.in[I_W0] + hj); pq[7] = *(const f32x4*)(a.in[I_W0] + hj + 4); pq[8] = *(const f32x4*)(a.in[I_A0] + hj); pq[9] = *(const f32x4*)(a.in[I_A0] + hj + 4);
            pq[10] = *(const f32x4*)(a.in[I_KK] + hj); pq[11] = *(const f32x4*)(a.in[I_KK] + hj + 4); pq[12] = *(const f32x4*)(a.in[I_KA] + hj); pq[13] = *(const f32x4*)(a.in[I_KA] + hj + 4);
            pq[14] = *(const f32x4*)(a.in[I_RK] + hj); pq[15] = *(const f32x4*)(a.in[I_RK] + hj + 4); }
        LBAR();
        float rr[8], kp[8], av[8], bv[8], lw[8];
        {   const size_t m = m0 + tj; const int hj = h * 64 + jb; const bool hasp = (t0 + tj) > 0;
            float x3[3][8];
#pragma unroll
            for (int q = 0; q < 3; ++q) { const int col = q * 512 + hj; const u32x4 p = q == 0 ? fr0 : q == 1 ? fk0 : fv0; const u32x4 s = q == 0 ? fr1 : q == 1 ? fk1 : fv1; (void)m; (void)hasp;
                const unsigned pw[4] = {p.x, p.y, p.z, p.w}, sw[4] = {s.x, s.y, s.z, s.w}; const f32x4 ma_ = pq[2 * q], mb_ = pq[2 * q + 1]; (void)col; const float mv[8] = {ma_.x, ma_.y, ma_.z, ma_.w, mb_.x, mb_.y, mb_.z, mb_.w};
#pragma unroll
                for (int e = 0; e < 4; ++e) { const float pl_ = bflo(pw[e]), ph_ = bfhi(pw[e]); x3[q][2 * e] = pl_ + (bflo(sw[e]) - pl_) * mv[2 * e]; x3[q][2 * e + 1] = ph_ + (bfhi(sw[e]) - ph_) * mv[2 * e + 1]; } }
            const f32x4 wp0 = *(const LAS f32x4*)(WP + tj * 68 + jb), wp1 = *(const LAS f32x4*)(WP + tj * 68 + jb + 4), ap0 = *(const LAS f32x4*)(AP + tj * 68 + jb), ap1 = *(const LAS f32x4*)(AP + tj * 68 + jb + 4);
            const float wpre[8] = {wp0.x, wp0.y, wp0.z, wp0.w, wp1.x, wp1.y, wp1.z, wp1.w}, apre[8] = {ap0.x, ap0.y, ap0.z, ap0.w, ap1.x, ap1.y, ap1.z, ap1.w};
            float ssq = 0.f, bon = 0.f, kkr[8];
#define LD8(arr, name) const f32x4 name##a_ = pq[arr], name##b_ = pq[arr + 1]; const float name[8] = {name##a_.x, name##a_.y, name##a_.z, name##a_.w, name##b_.x, name##b_.y, name##b_.z, name##b_.w}
            LD8(6, pw0); LD8(8, pa0); LD8(10, pkk); LD8(12, pka); LD8(14, prk);
#undef LD8
#pragma unroll
            for (int e = 0; e < 8; ++e) {
                const float wl = -fsoftplus(-(pw0[e] + wpre[e])) - 0.5f; lw[e] = -fexp(wl);
                const float aa = fsigm(pa0[e] + apre[e]);
                const float r = x3[0][e], k = x3[1][e]; *(LAS bf16_t*)(SL(7) + (jb + e) * PITCH + tj * 2) = (bf16_t)cvt1(x3[2][e]); rr[e] = r;
                kkr[e] = k * pkk[e]; ssq += kkr[e] * kkr[e];
                kp[e] = k * (1.0f + (aa - 1.0f) * pka[e]); bon += r * kp[e] * prk[e]; av[e] = aa;
            }
            ssq += __shfl_xor(ssq, 1); ssq += __shfl_xor(ssq, 2); ssq += __shfl_xor(ssq, 4);
            bon += __shfl_xor(bon, 1); bon += __shfl_xor(bon, 2); bon += __shfl_xor(bon, 4);
            const float inv = 1.0f / fmaxf(sqrtf(ssq), 1e-12f);
#pragma unroll
            for (int e = 0; e < 8; ++e) { const float kk = kkr[e] * inv; bv[e] = kk * av[e]; av[e] = -kk; }
            if ((tid & 7) == 0) ((float*)(a.ws + RS_GCB))[(size_t)it * 128 + 64 + tj] = bon;
            *(LAS f32x4*)(WP + tj * 68 + jb) = (f32x4){lw[0], lw[1], lw[2], lw[3]}; *(LAS f32x4*)(WP + tj * 68 + jb + 4) = (f32x4){lw[4], lw[5], lw[6], lw[7]};
        }
        LBAR();
        {   const int j = tid & 63, sg = tid >> 6; float run = 0.f;
#pragma unroll
            for (int u = 0; u < 8; ++u) { run += WP[(8 * sg + u) * 68 + j]; CL[(8 * sg + u) * 68 + j] = run; }
            SEG[sg * 68 + j] = run;
        }
        LBAR();
        {   const int j = tid & 63, sg = tid >> 6; float off = 0.f;
            for (int s = 0; s < sg; ++s) off += SEG[s * 68 + j];
#pragma unroll
            for (int u = 0; u < 8; ++u) CL[(8 * sg + u) * 68 + j] += off;
            if (sg == 7) CLAST[j] = off + SEG[7 * 68 + j];
        }
        LBAR();
        {   const f32x4 c0 = *(const LAS f32x4*)(CL + tj * 68 + jb), c1 = *(const LAS f32x4*)(CL + tj * 68 + jb + 4), e0 = *(const LAS f32x4*)(CLAST + jb), e1 = *(const LAS f32x4*)(CLAST + jb + 4);
            const float cl[8] = {c0.x, c0.y, c0.z, c0.w, c1.x, c1.y, c1.z, c1.w}, ce[8] = {e0.x, e0.y, e0.z, e0.w, e1.x, e1.y, e1.z, e1.w};
            float At[8], Rt[8], Bt[8], Kt[8], Bc[8], Kc[8];
#pragma unroll
            for (int e = 0; e < 8; ++e) { const float G = fexp(cl[e]), Gm1 = fexp(cl[e] - lw[e]), iG = fexp(-cl[e]), Gr = fexp(ce[e] - cl[e]);
                At[e] = av[e] * Gm1; Rt[e] = rr[e] * G; Bt[e] = bv[e] * iG; Kt[e] = kp[e] * iG; Bc[e] = bv[e] * Gr; Kc[e] = kp[e] * Gr; }
#define PK8(v) (u32x4){cvtpk(v[0], v[1]), cvtpk(v[2], v[3]), cvtpk(v[4], v[5]), cvtpk(v[6], v[7])}
            *(LAS u32x4*)(SL(0) + tj * PITCH + jb * 2) = PK8(At); *(LAS u32x4*)(SL(4) + tj * PITCH + jb * 2) = PK8(Rt);
            *(LAS u32x4*)(SL(1) + tj * PITCH + jb * 2) = PK8(Bt); *(LAS u32x4*)(SL(2) + tj * PITCH + jb * 2) = PK8(Kt);
#undef PK8
#pragma unroll
            for (int e = 0; e < 8; ++e) { *(LAS bf16_t*)(SL(3) + (jb + e) * PITCH + tj * 2) = (bf16_t)cvt1(At[e]); *(LAS bf16_t*)(SL(5) + (jb + e) * PITCH + tj * 2) = (bf16_t)cvt1(Bc[e]);
                *(LAS bf16_t*)(SL(6) + (jb + e) * PITCH + tj * 2) = (bf16_t)cvt1(Kc[e]); }
            if (tj == 0) { float* gc = (float*)(a.ws + RS_GCB) + (size_t)it * 128 + jb;
#pragma unroll
                for (int e = 0; e < 8; ++e) gc[e] = fexp(ce[e]); }
        }
        LBAR();
        if (it + nb < 4096) LOAD_RAW(it + nb);
        {   f32x16 acc = zero16(), acc2 = zero16();
            tile_nt(acc, grp == 0 ? SL(1) : SL(2), ta, SL(0), tb, r32, hi);
            tile_nt(acc2, grp == 0 ? SL(1) : SL(2), ta, SL(4), tb, r32, hi);
            const int tt = 32 * tb + r32;
#pragma unroll
            for (int r = 0; r < 16; ++r) { const int s = 32 * ta + crow(r, hi); acc[r] = s < tt ? acc[r] : 0.f; acc2[r] = s <= tt ? acc2[r] : 0.f; }
            if (grp == 0) { wr_t(SL(8), acc, ta, tb, r32, hi); wr_d(SL(9), acc, ta, tb, r32, hi);
#pragma unroll
                for (int r = 0; r < 16; ++r) acc[r] += (32 * ta + crow(r, hi) == tt) ? 1.0f : 0.f;
                wr_t(SL(13), acc, ta, tb, r32, hi); wr_t(SL(11), acc2, ta, tb, r32, hi); }
            else { wr_t(SL(10), acc, ta, tb, r32, hi); wr_t(SL(12), acc2, ta, tb, r32, hi); }
        }
        LBAR();
        {   f32x16 acc = zero16();
            if (grp == 0) { tile_nt(acc, SL(9), ta, SL(8), tb, r32, hi); wr_t(SL(0), acc, ta, tb, r32, hi); wr_d(SL(1), acc, ta, tb, r32, hi); }
            else { tile_nt(acc, SL(10), ta, SL(7), tb, r32, hi); wr_t(SL(14), acc, ta, tb, r32, hi); }
        }
        LBAR();
#pragma unroll
        for (int k = 1; k <= 3; ++k) {
            const int qr = (k & 1) ? 0 : 8, qt = qr + 1, qr2 = (k & 1) ? 8 : 0, qt2 = qr2 + 1, tr_ = (k & 1) ? 13 : 2, tr2 = (k & 1) ? 2 : 13;
            f32x16 acc = zero16();
            if (grp == 0) { if (k < 3) { tile_nt(acc, SL(qt), ta, SL(qr), tb, r32, hi); wr_t(SL(qr2), acc, ta, tb, r32, hi); wr_d(SL(qt2), acc, ta, tb, r32, hi); } }
            else { tile_nt(acc, SL(qt), ta, SL(tr_), tb, r32, hi);
#pragma unroll
                for (int q = 0; q < 4; ++q) { const u32x2 o = *(const LAS u32x2*)(SL(tr_) + (32 * tb + r32) * PITCH + (32 * ta + 8 * q + 4 * hi) * 2);
                    acc[4 * q] += bflo(o.x); acc[4 * q + 1] += bfhi(o.x); acc[4 * q + 2] += bflo(o.y); acc[4 * q + 3] += bfhi(o.y); }
                wr_t(SL(tr2), acc, ta, tb, r32, hi); }
            LBAR();
        }
        {   f32x16 acc = zero16();
            if (grp == 0) { tile_nt(acc, SL(2), ta, SL(3), tb, r32, hi); wr_t(SL(10), acc, ta, tb, r32, hi); }
            else { tile_nt(acc, SL(2), ta, SL(14), tb, r32, hi); wr_t(SL(15), acc, ta, tb, r32, hi); }
        }
        LBAR();
        {   unsigned char* ws = a.ws;
            if (grp == 0) {
                f32x16 acc = zero16(); tile_nt(acc, SL(10), ta, SL(11), tb, r32, hi);
                bf16_t* RH = (bf16_t*)(ws + RS_RH) + (size_t)it * 4096;
#pragma unroll
                for (int q = 0; q < 4; ++q) { const int t = 32 * tb + r32, j = 32 * ta + 8 * q + 4 * hi; const u32x2 o = *(const LAS u32x2*)(SL(4) + t * PITCH + j * 2);
                    u32x2 w; w.x = cvtpk(acc[4 * q] + bflo(o.x), acc[4 * q + 1] + bfhi(o.x)); w.y = cvtpk(acc[4 * q + 2] + bflo(o.y), acc[4 * q + 3] + bfhi(o.y)); *(u32x2*)(RH + t * 64 + j) = w; }
                f32x16 y = zero16(); tile_nt(y, SL(15), ta, SL(11), tb, r32, hi); tile_nt(y, SL(7), ta, SL(12), tb, r32, hi);
                bf16_t* Y0 = (bf16_t*)(ws + RS_Y0) + (size_t)it * 4096 + (tile * 64 + lane) * 16;
                *(u32x4*)Y0 = (u32x4){cvtpk(y[0], y[1]), cvtpk(y[2], y[3]), cvtpk(y[4], y[5]), cvtpk(y[6], y[7])}; *(u32x4*)(Y0 + 8) = (u32x4){cvtpk(y[8], y[9]), cvtpk(y[10], y[11]), cvtpk(y[12], y[13]), cvtpk(y[14], y[15])};
            } else {
                f32x16 acc = zero16(); tile_nt(acc, SL(10), ta, SL(5), tb, r32, hi);
                bf16_t* MP = (bf16_t*)(ws + RS_MP) + (size_t)it * 4096;
#pragma unroll
                for (int q = 0; q < 4; ++q) { const int j = 32 * tb + r32, j2 = 32 * ta + 8 * q + 4 * hi; u32x2 w; w.x = cvtpk(acc[4 * q], acc[4 * q + 1]); w.y = cvtpk(acc[4 * q + 2], acc[4 * q + 3]); *(u32x2*)(MP + j * 64 + j2) = w; }
                f32x16 n = zero16(); tile_nt(n, SL(5), ta, SL(15), tb, r32, hi); tile_nt(n, SL(6), ta, SL(7), tb, r32, hi);
                bf16_t* NN = (bf16_t*)(ws + RS_NN) + (size_t)it * 4096 + (tile * 64 + lane) * 16;
                *(u32x4*)NN = (u32x4){cvtpk(n[0], n[1]), cvtpk(n[2], n[3]), cvtpk(n[4], n[5]), cvtpk(n[6], n[7])}; *(u32x4*)(NN + 8) = (u32x4){cvtpk(n[8], n[9]), cvtpk(n[10], n[11]), cvtpk(n[12], n[13]), cvtpk(n[14], n[15])};
            }
        }
        LBAR();
    }
#undef SL
#undef LOAD_RAW
#undef LBAR
}

__device__ __forceinline__ void rwkv_pass2(const Args& a, LAS unsigned char* lds, int bid, int nb) {
    using namespace rk;
    const int tid = threadIdx.x, lane = tid & 63, wid = __builtin_amdgcn_readfirstlane(tid >> 6), r32 = lane & 31, hi = lane >> 5;
    const int ta = (wid & 3) >> 1, tb = wid & 1;
    for (int bh = bid; bh < 64; bh += nb) {
        __syncthreads();
        for (int e = tid; e < 2 * SLOT / 4; e += 512) ((LAS unsigned*)lds)[e] = 0u;
        __syncthreads();
        f32x16 st = zero16();
        if (wid < 4) {
            const bf16_t* MPb = (const bf16_t*)(a.ws + RS_MP) + (size_t)bh * 64 * 4096 + (32 * ta + r32) * 64 + 8 * hi;
            const float* gcb = (const float*)(a.ws + RS_GCB) + (size_t)bh * 64 * 128 + 32 * ta + 4 * hi;
            const bf16_t* NNb = (const bf16_t*)(a.ws + RS_NN) + (size_t)bh * 64 * 4096 + ((ta * 2 + tb) * 64 + lane) * 16;
            bf16x8 mfA[4], mfB[4], mfC[4]; f32x4 gA[4], gB[4], gC[4]; u32x4 nA0, nA1, nB0, nB1, nC0, nC1;
#define P2_LD(mf, g, n0, n1, cc) { const int c_ = (cc) < 62 ? (cc) : 62; \
                _Pragma("unroll") for (int ks = 0; ks < 4; ++ks) mf[ks] = *(const bf16x8*)(MPb + (size_t)c_ * 4096 + 16 * ks); \
                _Pragma("unroll") for (int q = 0; q < 4; ++q) g[q] = *(const f32x4*)(gcb + (size_t)c_ * 128 + 8 * q); \
                n0 = *(const u32x4*)(NNb + (size_t)c_ * 4096); n1 = *(const u32x4*)(NNb + (size_t)c_ * 4096 + 8); }
#define P2_STEP(mf, g, n0, n1, cc) { const int c_ = (cc); \
                const unsigned nw[8] = {n0.x, n0.y, n0.z, n0.w, n1.x, n1.y, n1.z, n1.w}; \
                _Pragma("unroll") for (int q = 0; q < 4; ++q) { \
                    st[4 * q] = st[4 * q] * g[q].x + bflo(nw[2 * q]); st[4 * q + 1] = st[4 * q + 1] * g[q].y + bfhi(nw[2 * q]); st[4 * q + 2] = st[4 * q + 2] * g[q].z + bflo(nw[2 * q + 1]); st[4 * q + 3] = st[4 * q + 3] * g[q].w + bfhi(nw[2 * q + 1]); } \
                const LAS unsigned char* pb = lds + (c_ & 1) * SLOT + (32 * tb + r32) * PITCH + 16 * hi;          \
                { const bf16x8 sf0_ = *(const LAS bf16x8*)(pb), sf1_ = *(const LAS bf16x8*)(pb + 32), sf2_ = *(const LAS bf16x8*)(pb + 64), sf3_ = *(const LAS bf16x8*)(pb + 96);     \
                  __builtin_amdgcn_sched_barrier(0); \
                  f32x16 s2_ = __builtin_amdgcn_mfma_f32_32x32x16_bf16(mf[2], sf2_, zero16(), 0, 0, 0);     \
                  st = __builtin_amdgcn_mfma_f32_32x32x16_bf16(mf[0], sf0_, st, 0, 0, 0); s2_ = __builtin_amdgcn_mfma_f32_32x32x16_bf16(mf[3], sf3_, s2_, 0, 0, 0); \
                  st = __builtin_amdgcn_mfma_f32_32x32x16_bf16(mf[1], sf1_, st, 0, 0, 0); _Pragma("unroll") for (int r_ = 0; r_ < 16; ++r_) st[r_] += s2_[r_]; } \
                  \
                LAS unsigned char* Sn = lds + ((c_ + 1) & 1) * SLOT; bf16_t* SG = (bf16_t*)(a.ws + RS_MP) + ((size_t)bh * 64 + c_) * 4096; \
                asm volatile("s_waitcnt lgkmcnt(0)" ::: "memory"); \
                __builtin_amdgcn_s_barrier(); asm volatile("" ::: "memory");    \
                _Pragma("unroll") for (int q = 0; q < 4; ++q) { u32x2 w; w.x = cvtpk(st[4 * q], st[4 * q + 1]); w.y = cvtpk(st[4 * q + 2], st[4 * q + 3]); \
                    const int i = 32 * tb + r32, j = 32 * ta + 8 * q + 4 * hi; \
                    *(LAS u32x2*)(Sn + i * PITCH + j * 2) = w; *(u32x2*)(SG + i * 64 + j) = w; } \
                asm volatile("s_waitcnt lgkmcnt(0)" ::: "memory"); \
                __builtin_amdgcn_s_barrier(); asm volatile("" ::: "memory"); }
            P2_LD(mfA, gA, nA0, nA1, 0) P2_LD(mfB, gB, nB0, nB1, 1)
#pragma unroll 1
            for (int c = 0; c < 63; c += 3) {
                P2_LD(mfC, gC, nC0, nC1, c + 2) P2_STEP(mfA, gA, nA0, nA1, c)
                P2_LD(mfA, gA, nA0, nA1, c + 3) P2_STEP(mfB, gB, nB0, nB1, c + 1)
                P2_LD(mfB, gB, nB0, nB1, c + 4) P2_STEP(mfC, gC, nC0, nC1, c + 2)
            }
#undef P2_LD
#undef P2_STEP
        } else {
            for (int c = 0; c < 63; ++c) { asm volatile("" ::: "memory"); __builtin_amdgcn_s_barrier(); asm volatile("" ::: "memory"); __builtin_amdgcn_s_barrier(); asm volatile("" ::: "memory"); }
        }
    }
}

__device__ __forceinline__ void rwkv_pass3(const Args& a, LAS unsigned char* lds, int bid, int nb) {
    using namespace rk;
    const int tid = threadIdx.x, lane = tid & 63, wid = tid >> 6, r32 = lane & 31, hi = lane >> 5;
    LAS unsigned char* vb = lds + wid * (72 * PITCH);
    const bf16_t* RW = (const bf16_t*)(a.ws + WS_RW); const float* mu = a.in[I_MU]; bf16_t* OB = (bf16_t*)(a.ws + WS_OB);
    const bf16_t* G2T = (const bf16_t*)(a.ws + WS_G2T);
    for (int it = bid * 8 + wid; it < 4096; it += nb * 8) {
        const int c = it & 63, h = (it >> 6) & 7, b = it >> 9;
        {
            const bf16_t* vsrc = RW + ((size_t)b * SEQ + 64 * c - 1 + (lane >> 3)) * 1792 + 1024 + h * 64 + (lane & 7) * 8;
#pragma unroll
            for (int k = 0; k < 9; ++k) { u32x4 w = (u32x4){0u, 0u, 0u, 0u}; if (c > 0 || k > 0 || (lane >> 3) > 0) w = *(const u32x4*)(vsrc + (size_t)(8 * k) * 1792);
                *(LAS u32x4*)(vb + (8 * k + (lane >> 3)) * PITCH + (lane & 7) * 16) = w; }
        }
        asm volatile("s_waitcnt lgkmcnt(0)" ::: "memory");
#pragma unroll 1
        for (int tbr = 0; tbr < 2; ++tbr) { const int tb = 1 - tbr;
            f32x16 y[2], g[2];
#pragma unroll
            for (int ia = 0; ia < 2; ++ia) { const bf16_t* Y0 = (const bf16_t*)(a.ws + RS_Y0) + (size_t)it * 4096 + ((ia * 2 + tb) * 64 + lane) * 16;
                const u32x4 v0 = *(const u32x4*)Y0, v1 = *(const u32x4*)(Y0 + 8); const unsigned w[8] = {v0.x, v0.y, v0.z, v0.w, v1.x, v1.y, v1.z, v1.w};
#pragma unroll
                for (int e = 0; e < 8; ++e) { y[ia][2 * e] = bflo(w[e]); y[ia][2 * e + 1] = bfhi(w[e]); }
                g[ia] = zero16(); }
            if (c > 0) {
                const bf16_t* S0 = (const bf16_t*)(a.ws + RS_MP) + (size_t)(it - 1) * 4096; const bf16_t* RH = (const bf16_t*)(a.ws + RS_RH) + (size_t)it * 4096 + (32 * tb + r32) * 64 + 8 * hi;
                bf16x8 rf[4], sf[2][4];
#pragma unroll
                for (int ks = 0; ks < 4; ++ks) { rf[ks] = *(const bf16x8*)(RH + 16 * ks);
#pragma unroll
                    for (int ia = 0; ia < 2; ++ia) sf[ia][ks] = *(const bf16x8*)(S0 + (32 * ia + r32) * 64 + 8 * hi + 16 * ks); }
#pragma unroll
                for (int ks = 0; ks < 4; ++ks)
#pragma unroll
                    for (int ia = 0; ia < 2; ++ia) y[ia] = __builtin_amdgcn_mfma_f32_32x32x16_bf16(sf[ia][ks], rf[ks], y[ia], 0, 0, 0);
            }
            const int t = 64 * c + 32 * tb + r32; const size_t m = (size_t)b * SEQ + t;
#pragma unroll 4
            for (int ks = 0; ks < 8; ++ks) {
                const int col = 1664 + 16 * ks + 8 * hi; const f32x4 ma_ = *(const f32x4*)(mu + col), mb_ = *(const f32x4*)(mu + col + 4); const float mv[8] = {ma_.x, ma_.y, ma_.z, ma_.w, mb_.x, mb_.y, mb_.z, mb_.w};
                const u32x4 p = *(const u32x4*)(RW + m * 1792 + col); u32x4 s = (u32x4){0u, 0u, 0u, 0u}; if (t > 0) s = *(const u32x4*)(RW + (m - 1) * 1792 + col);
                const unsigned pw[4] = {p.x, p.y, p.z, p.w}, sw[4] = {s.x, s.y, s.z, s.w}; float x[8];
#pragma unroll
                for (int e = 0; e < 4; ++e) { const float pl_ = bflo(pw[e]), ph_ = bfhi(pw[e]); x[2 * e] = fsigm(pl_ + (bflo(sw[e]) - pl_) * mv[2 * e]); x[2 * e + 1] = fsigm(ph_ + (bfhi(sw[e]) - ph_) * mv[2 * e + 1]); }
                const u32x4 xw = (u32x4){cvtpk(x[0], x[1]), cvtpk(x[2], x[3]), cvtpk(x[4], x[5]), cvtpk(x[6], x[7])}; const bf16x8 xf = __builtin_bit_cast(bf16x8, xw);
#pragma unroll
                for (int ia = 0; ia < 2; ++ia) g[ia] = __builtin_amdgcn_mfma_f32_32x32x16_bf16(*(const bf16x8*)(G2T + (size_t)(h * 64 + 32 * ia + r32) * 128 + 16 * ks + 8 * hi), xf, g[ia], 0, 0, 0);
            }
            float s = 0.f;
#pragma unroll
            for (int ia = 0; ia < 2; ++ia)
#pragma unroll
                for (int r = 0; r < 16; ++r) s += y[ia][r];
            s += __shfl_xor(s, 32); const float mean = s * (1.f / 64.f); float q = 0.f;
#pragma unroll
            for (int ia = 0; ia < 2; ++ia)
#pragma unroll
                for (int r = 0; r < 16; ++r) { y[ia][r] -= mean; q += y[ia][r] * y[ia][r]; }
            q += __shfl_xor(q, 32); const float rstd = rsqrtf(q * (1.f / 64.f) + GN_EPS);
            const float bon = ((const float*)(a.ws + RS_GCB))[(size_t)it * 128 + 64 + 32 * tb + r32];
            LAS unsigned char* rowc = vb + (32 * tb + r32 + 1) * PITCH;
            f32x4 nmq = *(const f32x4*)(mu + 1024 + h * 64 + 4 * hi), nlg = *(const f32x4*)(a.in[I_LNG] + h * 64 + 4 * hi), nlb = *(const f32x4*)(a.in[I_LNB] + h * 64 + 4 * hi);
#pragma unroll
            for (int ia = 0; ia < 2; ++ia)
#pragma unroll
                for (int qd = 0; qd < 4; ++qd) { const int i0 = 32 * ia + 8 * qd + 4 * hi;
                    const u32x2 p = *(const LAS u32x2*)(rowc + i0 * 2), sp = *(const LAS u32x2*)(rowc - PITCH + i0 * 2);
                    const float pv[4] = {bflo(p.x), bfhi(p.x), bflo(p.y), bfhi(p.y)}, sv[4] = {bflo(sp.x), bfhi(sp.x), bflo(sp.y), bfhi(sp.y)};
                    float o[4]; const f32x4 mq_ = nmq, lg_ = nlg, lb_ = nlb;
                    if (ia * 4 + qd < 7) { const int i1 = 32 * ((ia * 4 + qd + 1) >> 2) + 8 * ((ia * 4 + qd + 1) & 3) + 4 * hi; nmq = *(const f32x4*)(mu + 1024 + h * 64 + i1); nlg = *(const f32x4*)(a.in[I_LNG] + h * 64 + i1); nlb = *(const f32x4*)(a.in[I_LNB] + h * 64 + i1); }
#pragma unroll
                    for (int e = 0; e < 4; ++e) { const float v = pv[e] + (sv[e] - pv[e]) * mq_[e];
                        o[e] = (y[ia][4 * qd + e] * rstd * lg_[e] + lb_[e] + bon * v) * g[ia][4 * qd + e]; }
                    u32x2 w; w.x = cvtpk(o[0], o[1]); w.y = cvtpk(o[2], o[3]);
                    asm volatile("s_waitcnt lgkmcnt(0)" ::: "memory");
                    *(LAS u32x2*)(rowc + i0 * 2) = w; }
        }
        asm volatile("s_waitcnt lgkmcnt(0)" ::: "memory");
        {
            bf16_t* odst = OB + ((size_t)b * SEQ + 64 * c + (lane >> 3)) * 512 + h * 64 + (lane & 7) * 8;
#pragma unroll
            for (int k = 0; k < 8; ++k) *(u32x4*)(odst + (size_t)(8 * k) * 512) = *(const LAS u32x4*)(vb + (8 * k + (lane >> 3) + 1) * PITCH + (lane & 7) * 16);
        }
        asm volatile("s_waitcnt lgkmcnt(0)" ::: "memory");
    }
}
__device__ __forceinline__ void phase_convfix(const Args& a, int bid, int nb) {
    const float* U4 = (const float*)(a.ws + WS_U4); bf16_t* ACT = (bf16_t*)(a.ws + WS_ACT);
    const float* cw = a.in[I_CW]; const float* cb = a.in[I_CB];
    const int total = 256 * 2816;
    for (int e0 = bid * 512 + threadIdx.x; e0 < total; e0 += 3 * nb * 512) {
        float u0[3][2], u1[3][2], pm2[3][2], pm1[3][2], w0[3][2], w1[3][2], w2[3][2], bb[3][2];
#pragma unroll
        for (int q = 0; q < 3; ++q) { const int e = e0 + q * nb * 512; const bool ok = e < total; const int ee = ok ? e : 0;
            const int blk = ee / 2816, c = ee % 2816, tc = (c >> 7) * 256 + (c & 127); const bool first = (blk & 31) == 0; const int pb = first ? blk : blk - 1;
#pragma unroll
            for (int bj = 0; bj < 2; ++bj) { const int oc = bj * 2816 + c, tcc = tc + bj * 128;
                u0[q][bj] = U4[((size_t)blk * 4 + 0) * 5632 + tcc]; u1[q][bj] = U4[((size_t)blk * 4 + 1) * 5632 + tcc];
                const float a2 = U4[((size_t)pb * 4 + 2) * 5632 + tcc], a1 = U4[((size_t)pb * 4 + 3) * 5632 + tcc]; pm2[q][bj] = first ? 0.f : a2; pm1[q][bj] = first ? 0.f : a1;
                w0[q][bj] = cw[oc]; w1[q][bj] = cw[5632 + oc]; w2[q][bj] = cw[2 * 5632 + oc]; bb[q][bj] = cb[oc]; } }
#pragma unroll
        for (int q = 0; q < 3; ++q) { const int e = e0 + q * nb * 512; if (e < total) { const int blk = e / 2816, c = e % 2816;
            float cc[2][2];
#pragma unroll
            for (int bj = 0; bj < 2; ++bj) { cc[0][bj] = bb[q][bj] + w0[q][bj] * pm2[q][bj] + w1[q][bj] * pm1[q][bj] + w2[q][bj] * u0[q][bj];
                cc[1][bj] = bb[q][bj] + w0[q][bj] * pm1[q][bj] + w1[q][bj] * u0[q][bj] + w2[q][bj] * u1[q][bj]; }
#pragma unroll
            for (int r = 0; r < 2; ++r) { const float gt = cc[r][1]; ACT[(((size_t)(blk >> 1) * 44 + (c >> 6)) * 256 + (blk & 1) * 128 + r) * 64 + (c & 63)] = (bf16_t)f2bf(gt * sigmoidf_(gt) * cc[r][0]); } } }
    }
}

typedef GAS unsigned gu32;
#define RLX_AGENT __ATOMIC_RELAXED, __HIP_MEMORY_SCOPE_AGENT
#define XB_TMO      128
#define XB_XCNT(j)  (256  + 64 * (j))
#define XB_XSUB(j)  (1280 + 64 * (j))
#define XB_XGEN(j)  (2304 + 64 * (j))
#define XB_TOP      3328
#define XB_TOPGEN   3392
#define XCD_BAR_WORDS 3456
#define XB_SPIN_CAP (1u << 18)

__device__ __forceinline__ unsigned xb_ld(unsigned* p)              { return __hip_atomic_load(p, __ATOMIC_RELAXED, __HIP_MEMORY_SCOPE_AGENT); }
__device__ __forceinline__ unsigned xb_add(unsigned* p, unsigned v) { return __hip_atomic_fetch_add(p, v, __ATOMIC_RELAXED, __HIP_MEMORY_SCOPE_AGENT); }
__device__ __forceinline__ unsigned xb_xcc_id() { return (unsigned)__builtin_amdgcn_s_getreg((3 << 11) | 20) & 0xFu; }
#define XB_SPIN(cond, bar) do { unsigned _sp = 0; while (cond) { __builtin_amdgcn_s_sleep(1); \
    if ((++_sp & 255u) == 0u) { if (xb_ld(&(bar)[XB_TMO])) break; if (_sp > XB_SPIN_CAP) { atomicAdd(&(bar)[XB_TMO], 1u); break; } } } } while (0)

struct XcdBarrier {
    unsigned* bar; unsigned x;
    volatile LAS unsigned* st;
};

__device__ __forceinline__ XcdBarrier xcd_barrier_post(unsigned* bar, volatile LAS unsigned* st) {
    XcdBarrier b; b.bar = bar; b.x = xb_xcc_id(); b.st = st;
    if (threadIdx.x == 0) (void)xb_add(&bar[XB_XCNT(b.x)], 1u);
    return b;
}
__device__ __forceinline__ void xcd_barrier_complete(unsigned* bar, unsigned x, unsigned& nloc, unsigned& nx) {
    const unsigned G = gridDim.x * gridDim.y * gridDim.z;
    unsigned sum, cnt, mine, sp = 0u;
    for (;;) {
        sum = 0u; cnt = 0u; mine = 0u;
#pragma unroll
        for (unsigned j = 0; j < 16; ++j) { const unsigned c = xb_ld(&bar[XB_XCNT(j)]); sum += c; cnt += (c > 0u) ? 1u : 0u; mine = (j == x) ? c : mine; }
        if (sum == G) break;
        __builtin_amdgcn_s_sleep(1);
        if ((++sp & 255u) == 0u) { if (xb_ld(&bar[XB_TMO])) break; if (sp > XB_SPIN_CAP) { atomicAdd(&bar[XB_TMO], 1u); break; } }
    }
    nloc = mine > 0u ? mine : 1u; nx = cnt > 0u ? cnt : 1u;
}

__device__ __forceinline__ void xcd_barrier(const XcdBarrier& b) {
    asm volatile("s_waitcnt vmcnt(0)" ::: "memory");
    __syncthreads();
    if (threadIdx.x == 0) {
        unsigned* bar = b.bar;
        __builtin_amdgcn_s_waitcnt(0);
        unsigned nloc = b.st[0], nx = b.st[1];
        if (nloc == 0u) { xcd_barrier_complete(bar, b.x, nloc, nx); b.st[0] = nloc; b.st[1] = nx; }
        const unsigned old = xb_add(&bar[XB_XSUB(b.x)], 1u);
        const unsigned gen = old / nloc;
        if (old + 1u == (gen + 1u) * nloc) {
            __builtin_amdgcn_fence(__ATOMIC_RELEASE, "agent");
            asm volatile("s_waitcnt vmcnt(0)" ::: "memory");
            const unsigned og = xb_add(&bar[XB_TOP], 1u);
            const unsigned tg = og / nx;
            if (og + 1u == (tg + 1u) * nx) xb_add(&bar[XB_TOPGEN], 1u);
            else XB_SPIN(xb_ld(&bar[XB_TOPGEN]) == tg, bar);
            __builtin_amdgcn_fence(__ATOMIC_ACQUIRE, "agent");
            xb_add(&bar[XB_XGEN(b.x)], 1u);
            asm volatile("s_waitcnt vmcnt(0)" ::: "memory");
        } else {
            XB_SPIN(xb_ld(&bar[XB_XGEN(b.x)]) == gen, bar);
            __builtin_amdgcn_fence(__ATOMIC_ACQUIRE, "agent");
            asm volatile("s_waitcnt vmcnt(0)" ::: "memory");
        }
    }
    __syncthreads();
}

constexpr int N_PHASES = 17;
__global__ void __launch_bounds__(512, 2) mega(Args args) {
    extern __shared__ __attribute__((aligned(16))) unsigned char lds_raw[];
    LAS unsigned char* lds = (LAS unsigned char*)lds_raw;
    const int bid = blockIdx.x, nb = gridDim.x;
    unsigned char* ws = args.ws;
    volatile LAS unsigned* MISC = (volatile LAS unsigned*)(lds + 147456);
    if (threadIdx.x < 16) MISC[threadIdx.x] = 0u;
    __syncthreads();
    XcdBarrier xbar = xcd_barrier_post((unsigned*)(ws + WS_CTL) + 4096, MISC + 8);
#define GRID_SYNC() xcd_barrier(xbar)
#ifndef ONLY_PHASE
#define ONLY_PHASE -1
#endif
#define IN(k) ((ONLY_PHASE < 0 || ONLY_PHASE == (k)) && args.ph_lo <= (k) && (k) < args.ph_hi)
#ifndef REP_PHASE
#define REP_PHASE -1
#endif
#ifndef REP_N
#define REP_N 2
#endif
#define SEAM(k) do { if (args.ph_lo <= (k) && (k) + 1 < args.ph_hi) GRID_SYNC(); } while (0)
#define PHASE(k, ...) do { if (IN(k)) { for (int rep_ = 0; rep_ < (REP_PHASE == (k) ? REP_N : 1); ++rep_) { if (rep_) GRID_SYNC(); __VA_ARGS__ } } } while (0)
    PHASE(0, phase_prologue(args, lds, bid, nb);); SEAM(0);
    PHASE(1, { pg8::Gemm g{(const bf16_t*)(ws + WS_H), (const bf16_t*)(ws + WS_WIN), NT, NPROJ, 1024}; pg8::StaticOrder S; S.init(NT, NPROJ, nb, bid);
        { LAS f32x4* pl = (LAS f32x4*)(lds + 131072); const int t = threadIdx.x; pl[t] = ((const f32x4*)args.in[I_PEK])[t]; pl[512 + t] = ((const f32x4*)args.in[I_PEV])[t]; __syncthreads(); }
        pg8::EpiProj E{ws, args.in[I_QNG], args.in[I_KNG], (const LAS float*)(lds + 131072)};
        pg8::gemm_phase<pg8::EpiProj, pg8::StaticOrder, PG8_ALIGN, PG8_SP2>(lds, g, S, E); });
      SEAM(2);
    PHASE(3, {
        if (bid < 64) {
            const int tile = bid & 31, kh = bid >> 5, isv = tile >> 4;
            pg8::Gemm g{(const bf16_t*)(ws + (isv ? WS_FV : WS_FK)) + 1024 * kh, (const bf16_t*)(ws + (isv ? WS_WC1V : WS_WC1K)) + 1024 * kh, CMPROWS, 256, 1024, 2048};
            pg8::StaticOrder S; S.init(CMPROWS, 256, nb, tile & 15);
            if (kh) { pg8::EpiPartial E{ws, isv}; pg8::gemm_phase<pg8::EpiPartial, pg8::StaticOrder, false, PG8_SP2>(lds, g, S, E); }
            else { pg8::EpiCompress E{(const bf16_t*)(ws + WS_WC2T + (isv ? 32768 : 0)), (bf16_t*)(ws + (isv ? WS_VCB : WS_KCB)), isv ? nullptr : args.in[I_KNG], ws};
                   pg8::gemm_phase<pg8::EpiCompress, pg8::StaticOrder, false, PG8_SP2>(lds, g, S, E); } }
        else { if (bid == 64) { const int it = threadIdx.x >> 6, ln = threadIdx.x & 63;
                for (int k = 0; k < 4; ++k) { const int q = it * 4 + k; ((bf16_t*)(ws + ((q & 1) ? WS_VCB : WS_KCB)))[((size_t)(q >> 1) * 256 + 255) * 64 + ln] = 0; } }
            gates_items(args, (bid - 64) * 8 + (threadIdx.x >> 6), (nb - 64) * 8, threadIdx.x & 63); }
    });   SEAM(5);
    PHASE(6, phase_attn(args, lds, bid, nb);); SEAM(6);
    PHASE(7, rwkv_pass1(args, lds, bid, nb);); SEAM(7);
    PHASE(8, { if (bid < 64) rwkv_pass2(args, lds, bid, nb); else if (nb > 64) prologue_late_items(args, (LAS float*)(lds + (threadIdx.x >> 6) * 16384), (bid - 64) * 8 + (threadIdx.x >> 6), (nb - 64) * 8, threadIdx.x & 63); else {} if (nb <= 64) prologue_late_items(args, (LAS float*)(lds + (threadIdx.x >> 6) * 16384), bid * 8 + (threadIdx.x >> 6), nb * 8, threadIdx.x & 63); }); SEAM(8);
    PHASE(9, rwkv_pass3(args, lds, bid, nb);); SEAM(9);
    for (int rep8_ = 0; rep8_ < (REP_PHASE == 10 ? REP_N : 1); ++rep8_) {
    if (rep8_) GRID_SYNC();
    PHASE(10, { pg8::Gemm g{(const bf16_t*)(ws + WS_OA), (const bf16_t*)(ws + WS_WPA), NT, 1024, 512}; pg8::StaticOrder S; S.init(NT, 1024, nb, bid);
        pg8::EpiMerge<0> E{(const bf16_t*)(ws + WS_GA), (bf16_t*)(ws + WS_MRG)}; pg8::gemm_phase<pg8::EpiMerge<0>, pg8::StaticOrder, PG8_ALIGN, PG8_SP2>(lds, g, S, E); });
    PHASE(11, { pg8::Gemm g{(const bf16_t*)(ws + WS_OB), (const bf16_t*)(ws + WS_WPB), NT, 1024, 512}; pg8::StaticOrder S; S.init(NT, 1024, nb, bid);
        pg8::EpiMerge<1> E{(const bf16_t*)(ws + WS_GB), (bf16_t*)(ws + WS_MRG)}; pg8::gemm_phase<pg8::EpiMerge<1>, pg8::StaticOrder, PG8_ALIGN, PG8_SP2>(lds, g, S, E); });
    }
    SEAM(11);
    PHASE(12, { pg8::Gemm g{(const bf16_t*)(ws + WS_MRG), (const bf16_t*)(ws + WS_WOUT), NT, 1024, 1024}; pg8::StaticOrder S; S.init(NT, 1024, nb, bid);
        pg8::EpiResidNorm E{args.in[I_X], args.out, (bf16_t*)(ws + WS_H), (float*)(ws + WS_PS)}; pg8::gemm_phase<pg8::EpiResidNorm, pg8::StaticOrder, PG8_ALIGN, PG8_SP2>(lds, g, S, E); }); SEAM(12);
    PHASE(14, { pg8::Gemm g{(const bf16_t*)(ws + WS_H), (const bf16_t*)(ws + WS_WUP), NT, DFF2, 1024, 0, 1}; pg8::NormOrder S; S.init(NT, DFF2, nb, bid); S.PS = (const float*)(ws + WS_PS); S.tab = (LAS float*)(lds + 131072); S.last = 0; S.tag0 = -1; S.tag1 = -1;
        if (threadIdx.x < 2) ((LAS int*)(lds + 131072 + 2048))[threadIdx.x] = -1;
        __syncthreads();
        pg8::EpiUpConv E{(bf16_t*)(ws + WS_ACT), (float*)(ws + WS_U4), args.in[I_CW], args.in[I_CB], (const float*)(ws + WS_PS), lds + 131072}; pg8::gemm_phase<pg8::EpiUpConv, pg8::NormOrder, PG8_ALIGN, PG8_SP2>(lds, g, S, E); }); SEAM(14);
    PHASE(15, phase_convfix(args, bid, nb);); SEAM(15);
    PHASE(16, { pg8::Gemm g{(const bf16_t*)(ws + WS_ACT), (const bf16_t*)(ws + WS_WDN), NT, 1024, DFF, 0, 1}; pg8::StaticOrder S; S.init(NT, 1024, nb, bid);
        pg8::EpiResidB E{(const bf16_t*)(ws + WS_H), args.out}; pg8::gemm_phase<pg8::EpiResidB, pg8::StaticOrder, PG8_ALIGN, PG8_SP2>(lds, g, S, E); });
#undef PHASE
#undef IN
#undef SEAM
}

extern "C" void kernel_launch(void* const* d_in, const int* in_sizes, int n_in, void* d_out, int out_size, void* d_ws, size_t ws_size, hipStream_t stream) {
    static int grid = 0;
    if (grid == 0) {
        if (n_in != 31 || out_size != NT * DM || ws_size < WS_END) { fprintf(stderr, "kernel_launch: unexpected problem (n_in %d out %d ws %zu); nothing launched\n", n_in, out_size, ws_size); grid = -1; return; }
        int dev = 0, cus = 0, per_cu = 0;
        (void)hipGetDevice(&dev); (void)hipDeviceGetAttribute(&cus, hipDeviceAttributeMultiprocessorCount, dev);
        if (hipFuncSetAttribute((const void*)mega, hipFuncAttributeMaxDynamicSharedMemorySize, LDS_BYTES) != hipSuccess) { fprintf(stderr, "kernel_launch: hipFuncSetAttribute failed\n"); grid = -1; return; }
        (void)hipOccupancyMaxActiveBlocksPerMultiprocessor(&per_cu, (const void*)mega, 512, LDS_BYTES);
        (void)hipGetLastError();
        if (per_cu < 1) per_cu = 1;
        grid = cus;
        fprintf(stderr, "kernel_launch: cus %d occupancy/cu %d grid %d\n", cus, per_cu, grid);
    }
    if (grid < 0) return;
    Args a{};
    for (int i = 0; i < 31; ++i) a.in[i] = (const float*)d_in[i];
    a.out = (float*)d_out; a.ws = (unsigned char*)d_ws;
    a.ph_lo = 0; a.ph_hi = N_PHASES;
    if (hipMemsetAsync((char*)d_ws + WS_CTL, 0, 65536, stream) != hipSuccess) { fprintf(stderr, "kernel_launch: memset of the barrier words failed\n"); return; }
    hipLaunchKernelGGL(mega, dim3(grid), dim3(512), LDS_BYTES, stream, a);
}
```

```cpp
#include <hip/hip_runtime.h>
#include <cstdio>
#include <cstdint>

#define LAS __attribute__((address_space(3)))
#define GAS __attribute__((address_space(1)))
typedef unsigned short bf16_t;
typedef short bf16x8 __attribute__((ext_vector_type(8)));
typedef short s16x4 __attribute__((ext_vector_type(4)));
typedef float f32x2 __attribute__((ext_vector_type(2)));
typedef float f32x4 __attribute__((ext_vector_type(4)));
typedef float f32x16 __attribute__((ext_vector_type(16)));
typedef unsigned u32x2 __attribute__((ext_vector_type(2)));
typedef unsigned u32x4 __attribute__((ext_vector_type(4)));

constexpr int NB = 8, SEQ = 4096, DM = 1024, NT = NB * SEQ;
constexpr int NPROJ = 5120;
constexpr int QW = 512, KVW = 768, RWW = 1792, GTW = 24;
constexpr int DFF = 2816, DFF2 = 5632;
constexpr int NCMP = 255, CMPROWS = 4096;
constexpr float RMS_EPS = 1e-6f, GN_EPS = 64e-5f;
constexpr float LOG2E = 1.4426950408889634f;

constexpr size_t MiB = 1u << 20;
constexpr size_t WS_CTL = 0;
constexpr size_t WS_WIN = 1 * MiB;
constexpr size_t WS_WPA = 12 * MiB;
constexpr size_t WS_WPB = 13 * MiB;
constexpr size_t WS_WOUT = 14 * MiB;
constexpr size_t WS_WUP = 16 * MiB;
constexpr size_t WS_WDN = 27 * MiB;
constexpr size_t WS_WC1K = 33 * MiB;
constexpr size_t WS_WC1V = 34 * MiB;
constexpr size_t WS_MISC = 35 * MiB;
constexpr size_t WS_KC = WS_MISC, WS_VC = WS_MISC + 1 * MiB, WS_SEL = WS_MISC + 2 * MiB;
constexpr size_t WS_PS = WS_MISC;
constexpr size_t WS_WC2T = 38 * MiB + 262144;
constexpr size_t WS_KCB = 38 * MiB + 524288, WS_VCB = 39 * MiB;
constexpr size_t WS_H = 40 * MiB;
constexpr size_t WS_FK = 136 * MiB, WS_FV = 152 * MiB, WS_HK = 168 * MiB, WS_HV = 170 * MiB;
constexpr size_t WS_Q = 104 * MiB;
constexpr size_t WS_KV = 136 * MiB;
constexpr size_t WS_RW = 184 * MiB;
constexpr size_t WS_ACT = WS_Q;
constexpr size_t WS_MRG = WS_RW + 48 * MiB;
constexpr size_t WS_GA = 296 * MiB;
constexpr size_t WS_GB = 360 * MiB;
constexpr size_t WS_U4 = WS_GA;
constexpr size_t WS_GT = 424 * MiB;
constexpr size_t WS_KSN = 428 * MiB;
constexpr size_t WS_KWN = 436 * MiB;
constexpr size_t WS_OA = 444 * MiB;
constexpr size_t WS_OB = 476 * MiB;
constexpr size_t WS_VSN = WS_OB, WS_VWN = WS_OB + 8 * MiB;
constexpr size_t WS_OCMP = WS_OB;
constexpr size_t WS_END = 508 * MiB;

constexpr int LDS_BYTES = 147456 + 256;

__device__ __forceinline__ float bf2f(bf16_t v) { return __uint_as_float((unsigned)v << 16); }
__device__ __forceinline__ unsigned f2bf(float f) { unsigned u = __float_as_uint(f); return (u + 0x7fffu + ((u >> 16) & 1u)) >> 16; }
__device__ __forceinline__ unsigned pk2(float lo, float hi) { return f2bf(lo) | (f2bf(hi) << 16); }
__device__ __forceinline__ float bflo(unsigned w) { return __uint_as_float(w << 16); }
__device__ __forceinline__ float bfhi(unsigned w) { return __uint_as_float(w & 0xffff0000u); }
__device__ __forceinline__ float wave_sum(float v) {
#pragma unroll
    for (int o = 1; o < 64; o <<= 1) v += __shfl_xor(v, o);
    return v;
}
__device__ __forceinline__ float wave_max(float v) {
#pragma unroll
    for (int o = 1; o < 64; o <<= 1) v = fmaxf(v, __shfl_xor(v, o));
    return v;
}
__device__ __forceinline__ float sigmoidf_(float x) { return __builtin_amdgcn_rcpf(1.0f + __builtin_amdgcn_exp2f(-1.4426950408889634f * x)); }
__device__ __forceinline__ float gelu_tanh(float x) { const float z = 0.7978845608028654f * (x + 0.044715f * x * x * x); const float e = __builtin_amdgcn_exp2f(2.8853900817779268f * z); return x * (1.0f - __builtin_amdgcn_rcpf(e + 1.0f)); }
__device__ __forceinline__ int t5_bucket(int n) {
    if (n < 16) return n < 0 ? 0 : n;
    return 16 + (n >= 19) + (n >= 21) + (n >= 24) + (n >= 27) + (n >= 31) + (n >= 35) + (n >= 40) + (n >= 46) + (n >= 52) + (n >= 59) + (n >= 67) + (n >= 77) + (n >= 87) + (n >= 99) + (n >= 113);
}
namespace pg8 {
#define PG8_LAS __attribute__((address_space(3)))
typedef unsigned short bf16_t;
typedef short bf16x8 __attribute__((ext_vector_type(8)));
typedef float f32x4 __attribute__((ext_vector_type(4)));
typedef unsigned u32x4 __attribute__((ext_vector_type(4)));
constexpr int BM = 256, BK = 64, HALF = 128, HTB = HALF * BK * 2  , STAGE_BYTES = 8 * HTB, NXCD = 8, WGM = 8;

__host__ __device__ __forceinline__ int lds_byte(int r, int c) { const int st = (r >> 4) * 2 + (c >> 5), rr = r & 15, cc = c & 31, ob = rr * 64 + cc * 2; return st * 1024 + (ob ^ (((ob >> 9) & 1) << 5)); }
__host__ __device__ __forceinline__ void stage_rc(int b, int& R, int& C) { const int st = b / 1024, sb = b % 1024, swz = sb ^ (((sb >> 9) & 1) << 5); R = (st >> 1) * 16 + swz / 64; C = (st & 1) * 32 + (swz % 64) / 2; }
__host__ __device__ __forceinline__ int perm32(int rho) { const int n = rho >> 4, i = rho & 15; return 8 * (i >> 2) + 4 * n + (i & 3); }

struct Unit { int pm, pn; };
struct Gemm { const bf16_t* A; const bf16_t* Bt; int M, N, K; int ld; int ablk; int bblk; };

struct StaticOrder {
    int nM, nN, nwg, G, c;
    __host__ __device__ __forceinline__ void init(int M, int N, int G_, int c_) { nM = M / BM; nN = N / BM; nwg = nM * nN; G = G_; c = c_; }
    __host__ __device__ __forceinline__ bool next(int i, Unit& u) const {
        const long L = (long)i * G + c; if (L >= nwg) return false;
        int wgid = (int)L; { const int q = nwg / NXCD, r = nwg % NXCD, xcd = wgid % NXCD, off = wgid / NXCD; wgid = (xcd < r ? xcd * (q + 1) : r * (q + 1) + (xcd - r) * q) + off; }
        const int nig = WGM * nN, gid = wgid / nig, fm = gid * WGM, gsz = (nM - fm) < WGM ? (nM - fm) : WGM;
        u.pm = fm + ((wgid % nig) % gsz); u.pn = (wgid % nig) / gsz; return true;
    }
    __device__ __forceinline__ void a_ready(const Unit&) const {}
    __device__ __forceinline__ void done(const Unit&) const {}
};

struct NormOrder : StaticOrder {
    const float* PS; PG8_LAS float* tab; mutable int last, tag0, tag1;
    __device__ __forceinline__ void a_ready(const Unit& u) const {
        if ((last ? tag1 : tag0) == u.pm) return;
        last ^= 1; if (last) tag1 = u.pm; else tag0 = u.pm;
        const int tid = threadIdx.x;
        if (tid < 256) { const float* pp = PS + (size_t)(u.pm * BM + tid) * 16; const f32x4 a0 = *(const f32x4*)pp, a1 = *(const f32x4*)(pp + 4), a2 = *(const f32x4*)(pp + 8), a3 = *(const f32x4*)(pp + 12);
            tab[last * 256 + tid] = rsqrtf((((a0[0] + a0[1]) + (a0[2] + a0[3])) + ((a1[0] + a1[1]) + (a1[2] + a1[3])) + ((a2[0] + a2[1]) + (a2[2] + a2[3])) + ((a3[0] + a3[1]) + (a3[2] + a3[3]))) * (1.f / 1024.f) + 1e-6f); }
        if (tid == 0) ((PG8_LAS int*)(tab + 512))[last] = u.pm;
    }
};

__device__ __forceinline__ unsigned cvt_pk_bf16(float lo, float hi) { typedef float f2_ __attribute__((ext_vector_type(2))); typedef __bf16 b2_ __attribute__((ext_vector_type(2))); const f2_ v = {lo, hi}; const b2_ b = __builtin_convertvector(v, b2_); return __builtin_bit_cast(unsigned, b); }
typedef float f32x2 __attribute__((ext_vector_type(2)));
__device__ __forceinline__ float sigm(float x) { return __builtin_amdgcn_rcpf(1.0f + __builtin_amdgcn_exp2f(-1.4426950408889634f * x)); }
__device__ __forceinline__ f32x4 sigm4(f32x4 v) { return (f32x4){sigm(v[0]), sigm(v[1]), sigm(v[2]), sigm(v[3])}; }
__device__ __forceinline__ u32x4 pack8(f32x4 v0, f32x4 v1) { u32x4 w; w.x = cvt_pk_bf16(v0[0], v0[1]); w.y = cvt_pk_bf16(v0[2], v0[3]); w.z = cvt_pk_bf16(v1[0], v1[1]); w.w = cvt_pk_bf16(v1[2], v1[3]); return w; }
__device__ __forceinline__ float blo(unsigned w) { return __uint_as_float(w << 16); }
__device__ __forceinline__ float bhi(unsigned w) { return __uint_as_float(w & 0xffff0000u); }

struct EpiProj {
    static constexpr bool PERM = true, AFTER_DRAIN = false;
    unsigned char* ws; const float *qg, *kg; const PG8_LAS float* pel;
    __device__ __forceinline__ void operator()(const f32x4 (&acc)[2][2][4][2], const Unit& u, int wr, int wc, int fr, int fq) const {
        const int pn = u.pn; const int row0 = u.pm * BM + wr * 128 + fr;
        bf16_t* const Q = (bf16_t*)(ws + WS_Q); bf16_t* const FK = (bf16_t*)(ws + WS_FK); bf16_t* const FV = (bf16_t*)(ws + WS_FV); bf16_t* const KSN = (bf16_t*)(ws + WS_KSN); bf16_t* const KWN = (bf16_t*)(ws + WS_KWN);
        bf16_t* const VSN = (bf16_t*)(ws + WS_VSN); bf16_t* const VWN = (bf16_t*)(ws + WS_VWN); bf16_t* const RW = (bf16_t*)(ws + WS_RW); bf16_t* const GA = (bf16_t*)(ws + WS_GA); bf16_t* const GB = (bf16_t*)(ws + WS_GB); float* const GT = (float*)(ws + WS_GT);
        if (pn < 5) {
            const int d0 = 8 * fq;
            if (pn < 2 || (pn >= 3 && wc < 2)) {
                const float* gp = pn < 2 ? qg : kg; const float sc = pn < 2 ? 0.125f * 1.4426950408889634f : 1.0f;
                f32x4 gv[2][2];
#pragma unroll
                for (int bj = 0; bj < 2; ++bj)
#pragma unroll
                    for (int n = 0; n < 2; ++n) gv[bj][n] = *(const f32x4*)(gp + 32 * bj + d0 + 4 * n) * sc;
                bf16_t* base = pn < 2 ? Q + (4 * pn + wc) * 64 : (pn == 3 ? KSN : KWN) + wc * 64; const int ldc = pn < 2 ? 512 : 128;
#pragma unroll
                for (int ai = 0; ai < 2; ++ai)
#pragma unroll
                    for (int m = 0; m < 4; ++m) {
                        float ss = 0.f;
#pragma unroll
                        for (int bj = 0; bj < 2; ++bj)
#pragma unroll
                            for (int n = 0; n < 2; ++n) { const f32x4 v = acc[ai][bj][m][n]; ss += (v[0] * v[0] + v[1] * v[1]) + (v[2] * v[2] + v[3] * v[3]); }
                        ss += __shfl_xor(ss, 16); ss += __shfl_xor(ss, 32);
                        const float rs = rsqrtf(ss * (1.f / 64.f) + 1e-6f);
                        bf16_t* rowp = base + (size_t)(row0 + ai * 64 + m * 16) * ldc + d0;
#pragma unroll
                        for (int bj = 0; bj < 2; ++bj) *(u32x4*)(rowp + 32 * bj) = pack8(acc[ai][bj][m][0] * rs * gv[bj][0], acc[ai][bj][m][1] * rs * gv[bj][1]);
                    }
            } else if (pn >= 3) {
                bf16_t* base = (pn == 3 ? VSN : VWN) + (wc - 2) * 64;
#pragma unroll
                for (int ai = 0; ai < 2; ++ai)
#pragma unroll
                    for (int m = 0; m < 4; ++m) { bf16_t* rowp = base + (size_t)(row0 + ai * 64 + m * 16) * 128 + d0;
#pragma unroll
                        for (int bj = 0; bj < 2; ++bj) *(u32x4*)(rowp + 32 * bj) = pack8(acc[ai][bj][m][0], acc[ai][bj][m][1]); }
            } else {
                bf16_t* F = wc < 2 ? FK : FV; const PG8_LAS float* pe = pel + (wc < 2 ? 0 : 2048); const int g = wc & 1;
#pragma unroll
                for (int ai = 0; ai < 2; ++ai)
#pragma unroll
                    for (int m = 0; m < 4; ++m) { const int row = row0 + ai * 64 + m * 16; const int b = row >> 12, t = row & 4095, cb = t >> 4, l0 = t & 15;
#pragma unroll
                        for (int w = 0; w < 2; ++w) { const int cc = cb - w, l = l0 + 16 * w;
                            if (cc >= 0 && cc < 255) { bf16_t* rowp = F + ((size_t)((b * 255 + cc) * 2 + g)) * 2048 + l * 64 + d0; const PG8_LAS float* pp = pe + l * 64 + d0;
#pragma unroll
                                for (int bj = 0; bj < 2; ++bj) *(u32x4*)(rowp + 32 * bj) = pack8(acc[ai][bj][m][0] + *(const PG8_LAS f32x4*)(pp + 32 * bj), acc[ai][bj][m][1] + *(const PG8_LAS f32x4*)(pp + 32 * bj + 4)); } } }
            }
        } else if (pn < 20) {
            bf16_t* base; int ldc, colt; bool sg = false;
            if (pn < 12) { base = RW; ldc = 1792; colt = (pn - 5) * 256; }
            else if (pn < 16) { base = GA; ldc = 1024; colt = (pn - 12) * 256; sg = true; }
            else { base = GB; ldc = 1024; colt = (pn - 16) * 256; sg = true; }
            const int col0 = colt + wc * 32 + 8 * fq;
#pragma unroll
            for (int ai = 0; ai < 2; ++ai)
#pragma unroll
                for (int m = 0; m < 4; ++m) { bf16_t* rowp = base + (size_t)(row0 + ai * 64 + m * 16) * ldc + col0;
                    if (sg) {
                        unsigned char* rowq = (unsigned char*)base + (size_t)(row0 + ai * 64 + m * 16) * 1024 + col0;
#pragma unroll
                        for (int bj = 0; bj < 2; ++bj) { u32x2 w;
#pragma unroll
                            for (int n = 0; n < 2; ++n) { const f32x4 v = acc[ai][bj][m][n]; unsigned p = 0u;
#pragma unroll
                                for (int e = 0; e < 4; ++e) p = __builtin_amdgcn_cvt_pk_u8_f32(__builtin_amdgcn_rcpf(__builtin_amdgcn_exp2f(-1.4426950408889634f * v[e]) * (1.f / 255.f) + (1.f / 255.f)), e, p);
                                if (n == 0) w.x = p; else w.y = p; }
                            *(u32x2*)(rowq + bj * HALF) = w; }
                    } else {
#pragma unroll
                    for (int bj = 0; bj < 2; ++bj) { f32x4 v0 = acc[ai][bj][m][0], v1 = acc[ai][bj][m][1];
                        *(u32x4*)(rowp + bj * HALF) = pack8(v0, v1); } } }
        } else {
            if (wc == 0 && fq < 3) {
#pragma unroll
                for (int ai = 0; ai < 2; ++ai)
#pragma unroll
                    for (int m = 0; m < 4; ++m) { float* rowp = GT + (size_t)(row0 + ai * 64 + m * 16) * 24 + 8 * fq;
#pragma unroll
                        for (int n = 0; n < 2; ++n) *(f32x4*)(rowp + 4 * n) = sigm4(acc[ai][0][m][n]); }
            }
        }
    }
};
template <int ACT> struct EpiBf16 {
    static constexpr bool PERM = true, AFTER_DRAIN = false;
    bf16_t* O; int ldc;
    __device__ __forceinline__ void operator()(const f32x4 (&acc)[2][2][4][2], const Unit& u, int wr, int wc, int fr, int fq) const {
        const int row0 = u.pm * BM + wr * 128 + fr, col0 = u.pn * BM + wc * 32 + 8 * fq;
#pragma unroll
        for (int ai = 0; ai < 2; ++ai)
#pragma unroll
            for (int m = 0; m < 4; ++m) { bf16_t* rowp = O + (size_t)(row0 + ai * 64 + m * 16) * ldc + col0;
#pragma unroll
                for (int bj = 0; bj < 2; ++bj) { f32x4 v0 = acc[ai][bj][m][0], v1 = acc[ai][bj][m][1];
                    if (ACT == 1) { v0 = (f32x4){gelu_tanh(v0[0]), gelu_tanh(v0[1]), gelu_tanh(v0[2]), gelu_tanh(v0[3])}; v1 = (f32x4){gelu_tanh(v1[0]), gelu_tanh(v1[1]), gelu_tanh(v1[2]), gelu_tanh(v1[3])}; }
                    *(u32x4*)(rowp + bj * HALF) = pack8(v0, v1); } }
    }
};
struct EpiPartial {
    static constexpr bool PERM = true, AFTER_DRAIN = false;
    unsigned char* wsb; int isv;
    __device__ __forceinline__ void operator()(const f32x4 (&acc)[2][2][4][2], const Unit& u, int, int, int, int) const {
        const int tile = isv * 16 + u.pm; float* part = (float*)(wsb + 172 * MiB) + (size_t)tile * 65536; unsigned* flag = (unsigned*)(wsb + 49152) + 64 * tile;
        f32x4* p = (f32x4*)part + threadIdx.x;
#pragma unroll
        for (int ai = 0; ai < 2; ++ai)
#pragma unroll
            for (int bj = 0; bj < 2; ++bj)
#pragma unroll
                for (int m = 0; m < 4; ++m)
#pragma unroll
                    for (int n = 0; n < 2; ++n) p[(size_t)(((ai * 2 + bj) * 4 + m) * 2 + n) * 512] = acc[ai][bj][m][n];
        asm volatile("s_waitcnt vmcnt(0)" ::: "memory");
        __syncthreads();
        if (threadIdx.x == 0) { __builtin_amdgcn_fence(__ATOMIC_RELEASE, "agent"); asm volatile("s_waitcnt vmcnt(0)" ::: "memory");
            __hip_atomic_store(flag, 1u, __ATOMIC_RELAXED, __HIP_MEMORY_SCOPE_AGENT); }
    }
};
struct EpiCompress {
    static constexpr bool PERM = true, AFTER_DRAIN = true;
    const bf16_t* W2T;
    bf16_t* OUT;
    const float* kg;
    unsigned char* wsb;
    __device__ __forceinline__ void fused(f32x4 (&acc)[2][2][4][2], const Unit& u, int wr, int wc, int fr, int fq, PG8_LAS unsigned char* lds, int wid, int lane) const {
        constexpr int HP = 528;
        {
            const int tile = (kg ? 0 : 16) + u.pm; const float* part = (const float*)(wsb + 172 * MiB) + (size_t)tile * 65536; unsigned* flag = (unsigned*)(wsb + 49152) + 64 * tile;
            if (threadIdx.x == 0) { while (__hip_atomic_load(flag, __ATOMIC_RELAXED, __HIP_MEMORY_SCOPE_AGENT) == 0u) __builtin_amdgcn_s_sleep(1);
                __builtin_amdgcn_fence(__ATOMIC_ACQUIRE, "agent"); asm volatile("s_waitcnt vmcnt(0)" ::: "memory"); }
            __syncthreads();
            const f32x4* p = (const f32x4*)part + threadIdx.x;
#pragma unroll
            for (int ai = 0; ai < 2; ++ai)
#pragma unroll
                for (int bj = 0; bj < 2; ++bj) {
                    f32x4 t[4][2];
#pragma unroll
                    for (int m = 0; m < 4; ++m)
#pragma unroll
                        for (int n = 0; n < 2; ++n) t[m][n] = p[(size_t)(((ai * 2 + bj) * 4 + m) * 2 + n) * 512];
#pragma unroll
                    for (int m = 0; m < 4; ++m)
#pragma unroll
                        for (int n = 0; n < 2; ++n) acc[ai][bj][m][n] = acc[ai][bj][m][n] + t[m][n];
                    asm volatile("" ::: "memory"); }
        }
#pragma unroll
        for (int ai = 0; ai < 2; ++ai)
#pragma unroll
            for (int m = 0; m < 4; ++m) { const int r = wr * 128 + ai * 64 + m * 16 + fr;
#pragma unroll
                for (int bj = 0; bj < 2; ++bj) { const f32x4 v0 = acc[ai][bj][m][0], v1 = acc[ai][bj][m][1];
                    *(PG8_LAS u32x4*)(lds + r * HP + (bj * 128 + wc * 32 + 8 * fq) * 2) = pack8((f32x4){gelu_tanh(v0[0]), gelu_tanh(v0[1]), gelu_tanh(v0[2]), gelu_tanh(v0[3])}, (f32x4){gelu_tanh(v1[0]), gelu_tanh(v1[1]), gelu_tanh(v1[2]), gelu_tanh(v1[3])}); } }
        asm volatile("s_waitcnt lgkmcnt(0)" ::: "memory"); __builtin_amdgcn_s_barrier(); asm volatile("" ::: "memory");
        typedef float f32x16_ __attribute__((ext_vector_type(16)));
        const int r32 = lane & 31, hi = lane >> 5;
        f32x16_ o0 = (f32x16_){0.f, 0.f, 0.f, 0.f, 0.f, 0.f, 0.f, 0.f, 0.f, 0.f, 0.f, 0.f, 0.f, 0.f, 0.f, 0.f}, o1 = o0;
        const PG8_LAS unsigned char* hb = lds + (32 * wid + r32) * HP + 16 * hi;
        const bf16_t* wa = W2T + (size_t)r32 * 256 + 8 * hi;
#pragma unroll 4
        for (int ks = 0; ks < 16; ++ks) { const bf16x8 hf = *(const PG8_LAS bf16x8*)(hb + 32 * ks);
            o0 = __builtin_amdgcn_mfma_f32_32x32x16_bf16(*(const bf16x8*)(wa + 16 * ks), hf, o0, 0, 0, 0);
            o1 = __builtin_amdgcn_mfma_f32_32x32x16_bf16(*(const bf16x8*)(wa + 32 * 256 + 16 * ks), hf, o1, 0, 0, 0); }
        float rs = 1.0f;
        if (kg) { float ss = 0.f;
#pragma unroll
            for (int r = 0; r < 16; ++r) ss += o0[r] * o0[r] + o1[r] * o1[r];
            ss += __shfl_xor(ss, 32); rs = rsqrtf(ss * (1.f / 64.f) + 1e-6f); }
        const int R = u.pm * BM + 32 * wid + r32;
        if (R < 4080) { const int g = R & 1, bc = R >> 1, b = bc / 255, c = bc - b * 255; bf16_t* op = OUT + ((size_t)(b * 2 + g) * 256 + c) * 64 + 4 * hi;
#pragma unroll
            for (int q = 0; q < 4; ++q) { f32x4 a0 = (f32x4){o0[4 * q], o0[4 * q + 1], o0[4 * q + 2], o0[4 * q + 3]} * rs, a1 = (f32x4){o1[4 * q], o1[4 * q + 1], o1[4 * q + 2], o1[4 * q + 3]} * rs;
                if (kg) { a0 = a0 * *(const f32x4*)(kg + 8 * q + 4 * hi); a1 = a1 * *(const f32x4*)(kg + 32 + 8 * q + 4 * hi); }
                typedef unsigned u32x2_ __attribute__((ext_vector_type(2)));
                u32x2_ w0; w0.x = cvt_pk_bf16(a0[0], a0[1]); w0.y = cvt_pk_bf16(a0[2], a0[3]); u32x2_ w1; w1.x = cvt_pk_bf16(a1[0], a1[1]); w1.y = cvt_pk_bf16(a1[2], a1[3]);
                *(u32x2_*)(op + 8 * q) = w0; *(u32x2_*)(op + 32 + 8 * q) = w1; } }
    }
};
template <int MODE> struct EpiMerge {
    static constexpr bool PERM = true, AFTER_DRAIN = false;
    const unsigned char* G; bf16_t* O;
    __device__ __forceinline__ void operator()(const f32x4 (&acc)[2][2][4][2], const Unit& u, int wr, int wc, int fr, int fq) const {
        const int row0 = u.pm * BM + wr * 128 + fr, col0 = u.pn * BM + wc * 32 + 8 * fq;
#pragma unroll
        for (int ai = 0; ai < 2; ++ai) {
            u32x2 gq[4][2]; u32x4 oq[4][2];
#pragma unroll
            for (int m = 0; m < 4; ++m) { const size_t off = (size_t)(row0 + ai * 64 + m * 16) * 1024 + col0;
#pragma unroll
                for (int bj = 0; bj < 2; ++bj) { gq[m][bj] = *(const u32x2*)(G + off + bj * HALF); if (MODE == 1) oq[m][bj] = *(const u32x4*)(O + off + bj * HALF); } }
#pragma unroll
            for (int m = 0; m < 4; ++m) { const size_t off = (size_t)(row0 + ai * 64 + m * 16) * 1024 + col0;
#pragma unroll
                for (int bj = 0; bj < 2; ++bj) { const u32x2 g = gq[m][bj];
                    f32x4 v0 = acc[ai][bj][m][0], v1 = acc[ai][bj][m][1];
                    v0 = v0 * (f32x4){(float)(g.x & 255u), (float)((g.x >> 8) & 255u), (float)((g.x >> 16) & 255u), (float)(g.x >> 24)}; v1 = v1 * (f32x4){(float)(g.y & 255u), (float)((g.y >> 8) & 255u), (float)((g.y >> 16) & 255u), (float)(g.y >> 24)};
                    if (MODE == 1) { const u32x4 o = oq[m][bj];
                        v0 = v0 + (f32x4){blo(o.x), bhi(o.x), blo(o.y), bhi(o.y)}; v1 = v1 + (f32x4){blo(o.z), bhi(o.z), blo(o.w), bhi(o.w)}; }
                    *(u32x4*)(O + off + bj * HALF) = pack8(v0, v1); } } }
    }
};
struct EpiResid {
    static constexpr bool PERM = false, AFTER_DRAIN = false;
    const float* base; float* out;
    __device__ __forceinline__ void operator()(const f32x4 (&acc)[2][2][4][2], const Unit& u, int wr, int wc, int fr, int fq) const {
        const int row0 = u.pm * BM + wr * 128 + fr, col0 = u.pn * BM + wc * 32 + 4 * fq;
#pragma unroll
        for (int ai = 0; ai < 2; ++ai)
#pragma unroll
            for (int m = 0; m < 4; ++m) { const size_t off = (size_t)(row0 + ai * 64 + m * 16) * 1024 + col0;
#pragma unroll
                for (int bj = 0; bj < 2; ++bj)
#pragma unroll
                    for (int n = 0; n < 2; ++n) { const f32x4 b = *(const f32x4*)(base + off + bj * HALF + n * 16); *(f32x4*)(out + off + bj * HALF + n * 16) = b + acc[ai][bj][m][n]; } }
    }
};
#define XBLK_BASE(u, wr, wc, fr, fq) ((((size_t)(u).pm * 16 + (u).pn * 4 + ((wc) >> 1)) * 256 + ((wr) * 128 + (fr))) * 64 + ((wc) & 1) * 32 + 4 * (fq))
#define XBLK_PIECE(ai, m, bj, n) ((bj) * 32768 + (ai) * 4096 + (m) * 1024 + (n) * 16)
struct EpiResidB {
    static constexpr bool PERM = false, AFTER_DRAIN = false;
    const bf16_t* base; float* out;
    __device__ __forceinline__ void operator()(const f32x4 (&acc)[2][2][4][2], const Unit& u, int wr, int wc, int fr, int fq) const {
        const int row0 = u.pm * BM + wr * 128 + fr, col0 = u.pn * BM + wc * 32 + 4 * fq;
        typedef unsigned u32x2_ __attribute__((ext_vector_type(2)));
        const bf16_t* const xb0 = base + XBLK_BASE(u, wr, wc, fr, fq);
        u32x2_ rb[2][4][2][2];
#pragma unroll
        for (int ai = 0; ai < 2; ++ai)
#pragma unroll
            for (int m = 0; m < 4; ++m) { const size_t off = (size_t)(row0 + ai * 64 + m * 16) * 1024 + col0;
#pragma unroll
                for (int bj = 0; bj < 2; ++bj)
#pragma unroll
                    for (int n = 0; n < 2; ++n) rb[ai][m][bj][n] = *(const u32x2_*)(xb0 + XBLK_PIECE(ai, m, bj, n)); }
#pragma unroll
        for (int ai = 0; ai < 2; ++ai)
#pragma unroll
            for (int m = 0; m < 4; ++m) { const size_t off = (size_t)(row0 + ai * 64 + m * 16) * 1024 + col0;
#pragma unroll
                for (int bj = 0; bj < 2; ++bj)
#pragma unroll
                    for (int n = 0; n < 2; ++n) { const u32x2_ b = rb[ai][m][bj][n]; *(f32x4*)(out + off + bj * HALF + n * 16) = (f32x4){blo(b.x), bhi(b.x), blo(b.y), bhi(b.y)} + acc[ai][bj][m][n]; } }
    }
};
struct EpiResidNorm {
    static constexpr bool PERM = false, AFTER_DRAIN = false;
    const float* base; float* out; bf16_t* XB; float* PS;
    __device__ __forceinline__ void operator()(const f32x4 (&acc)[2][2][4][2], const Unit& u, int wr, int wc, int fr, int fq) const {
        const int row0 = u.pm * BM + wr * 128 + fr, col0 = u.pn * BM + wc * 32 + 4 * fq;
        typedef unsigned u32x2_ __attribute__((ext_vector_type(2)));
        bf16_t* const xb0 = XB + XBLK_BASE(u, wr, wc, fr, fq);
#pragma unroll
        for (int ai = 0; ai < 2; ++ai) {
            f32x4 xr[4][2][2];
#pragma unroll
            for (int m = 0; m < 4; ++m) { const size_t off = (size_t)(row0 + ai * 64 + m * 16) * 1024 + col0;
#pragma unroll
                for (int bj = 0; bj < 2; ++bj)
#pragma unroll
                    for (int n = 0; n < 2; ++n) xr[m][bj][n] = *(const f32x4*)(base + off + bj * HALF + n * 16); }
#pragma unroll
            for (int m = 0; m < 4; ++m) { const int row = row0 + ai * 64 + m * 16; const size_t off = (size_t)row * 1024 + col0; float ss = 0.f;
#pragma unroll
                for (int bj = 0; bj < 2; ++bj)
#pragma unroll
                    for (int n = 0; n < 2; ++n) { const f32x4 v = xr[m][bj][n] + acc[ai][bj][m][n];
                        u32x2_ w; w.x = cvt_pk_bf16(v[0], v[1]); w.y = cvt_pk_bf16(v[2], v[3]); *(u32x2_*)(xb0 + XBLK_PIECE(ai, m, bj, n)) = w;
                        ss += (v[0] * v[0] + v[1] * v[1]) + (v[2] * v[2] + v[3] * v[3]); }
                ss += __shfl_xor(ss, 16); ss += __shfl_xor(ss, 32);
                if (fq == 0) PS[(size_t)row * 16 + u.pn * 4 + wc] = ss; } }
    }
};
#ifndef USE_DPP
#define USE_DPP 1
#endif
__device__ __forceinline__ float dpp_prev1(float cur, float prv) {
#if USE_DPP
    const int t = __builtin_amdgcn_update_dpp(0, __float_as_int(prv), 0x10F  , 0xF, 0xF, true);
    return __int_as_float(__builtin_amdgcn_update_dpp(t, __float_as_int(cur), 0x111  , 0xF, 0xF, false));
#else
    const int lane = threadIdx.x & 63; const float a = __shfl(cur, lane - 1), b = __shfl(prv, lane + 15); return (lane & 15) >= 1 ? a : b;
#endif
}
__device__ __forceinline__ float dpp_prev2(float cur, float prv) {
#if USE_DPP
    const int t = __builtin_amdgcn_update_dpp(0, __float_as_int(prv), 0x10E  , 0xF, 0xF, true);
    return __int_as_float(__builtin_amdgcn_update_dpp(t, __float_as_int(cur), 0x112  , 0xF, 0xF, false));
#else
    const int lane = threadIdx.x & 63; const float a = __shfl(cur, lane - 2), b = __shfl(prv, lane + 14); return (lane & 15) >= 2 ? a : b;
#endif
}
struct EpiUpConv {
    static constexpr bool PERM = true, AFTER_DRAIN = false;
    bf16_t* ACT; float* U4; const float* cw; const float* cb; const float* PS; PG8_LAS unsigned char* rstd_lds;
    __device__ __forceinline__ void operator()(const f32x4 (&acc)[2][2][4][2], const Unit& u, int wr, int wc, int fr, int fq) const {
        const int row0 = u.pm * BM + wr * 128 + fr;
        const int cv0 = u.pn * 128 + wc * 32 + 8 * fq;
        const int blk = u.pm * 2 + wr;
        bf16_t* const actb = ACT + (((size_t)u.pm * 44 + 2 * u.pn + (wc >> 1)) * 256 + wr * 128 + fr) * 64 + (wc & 1) * 32 + 8 * fq;
        f32x4 (&A)[2][2][4][2] = const_cast<f32x4 (&)[2][2][4][2]>(acc);
        {   const PG8_LAS int* tg = (const PG8_LAS int*)((PG8_LAS float*)rstd_lds + 512); const PG8_LAS float* rt = (const PG8_LAS float*)rstd_lds + (tg[0] == u.pm ? 0 : 256);
#pragma unroll
            for (int mm = 0; mm < 8; ++mm) { const float rs = rt[wr * 128 + mm * 16 + fr];
#pragma unroll
                for (int bj = 0; bj < 2; ++bj)
#pragma unroll
                    for (int n = 0; n < 2; ++n) A[mm >> 2][bj][mm & 3][n] = A[mm >> 2][bj][mm & 3][n] * rs; }
        }
#pragma unroll
        for (int n = 0; n < 2; ++n) {
            f32x4 w0[2], w1[2], w2[2], bb[2];
#pragma unroll
            for (int bj = 0; bj < 2; ++bj) { const int c = bj * 2816 + cv0 + 4 * n;
                w0[bj] = *(const f32x4*)(cw + c); w1[bj] = *(const f32x4*)(cw + 5632 + c); w2[bj] = *(const f32x4*)(cw + 2 * 5632 + c); bb[bj] = *(const f32x4*)(cb + c); }
            {   const int tc = u.pn * 256 + wc * 32 + 8 * fq + 4 * n;
                if (fr < 2) {
#pragma unroll
                    for (int bj = 0; bj < 2; ++bj) *(f32x4*)(U4 + ((size_t)blk * 4 + fr) * 5632 + tc + bj * 128) = acc[0][bj][0][n]; }
                if (fr >= 14) {
#pragma unroll
                    for (int bj = 0; bj < 2; ++bj) *(f32x4*)(U4 + ((size_t)blk * 4 + 2 + (fr - 14)) * 5632 + tc + bj * 128) = acc[1][bj][3][n]; }
            }
#pragma unroll
            for (int mm = 0; mm < 8; ++mm) { const int ai = mm >> 2, m = mm & 3;
                f32x4 c[2];
#pragma unroll
                for (int bj = 0; bj < 2; ++bj) {
                    const f32x4 cur = acc[ai][bj][m][n]; const f32x4 prv = (mm == 0) ? (f32x4){0.f, 0.f, 0.f, 0.f} : acc[(mm - 1) >> 2][bj][(mm - 1) & 3][n];
#pragma unroll
                    for (int e = 0; e < 4; ++e) c[bj][e] = fmaf(w2[bj][e], cur[e], bb[bj][e]);
                    {   float c0 = c[bj][0], c1 = c[bj][1], c2 = c[bj][2], c3 = c[bj][3];
                        asm volatile("s_nop 1\n\t"
                                     "v_fmac_f32_dpp %0, %4, %8 row_shr:1 row_mask:0xf bank_mask:0xf bound_ctrl:1\n\tv_fmac_f32_dpp %1, %5, %9 row_shr:1 row_mask:0xf bank_mask:0xf bound_ctrl:1\n\t"
                                     "v_fmac_f32_dpp %2, %6, %10 row_shr:1 row_mask:0xf bank_mask:0xf bound_ctrl:1\n\tv_fmac_f32_dpp %3, %7, %11 row_shr:1 row_mask:0xf bank_mask:0xf bound_ctrl:1\n\t"
                                     "v_fmac_f32_dpp %0, %4, %12 row_shr:2 row_mask:0xf bank_mask:0xf bound_ctrl:1\n\tv_fmac_f32_dpp %1, %5, %13 row_shr:2 row_mask:0xf bank_mask:0xf bound_ctrl:1\n\t"
                                     "v_fmac_f32_dpp %2, %6, %14 row_shr:2 row_mask:0xf bank_mask:0xf bound_ctrl:1\n\tv_fmac_f32_dpp %3, %7, %15 row_shr:2 row_mask:0xf bank_mask:0xf bound_ctrl:1"
                                     : "+v"(c0), "+v"(c1), "+v"(c2), "+v"(c3)
                                     : "v"(cur[0]), "v"(cur[1]), "v"(cur[2]), "v"(cur[3]), "v"(w1[bj][0]), "v"(w1[bj][1]), "v"(w1[bj][2]), "v"(w1[bj][3]), "v"(w0[bj][0]), "v"(w0[bj][1]), "v"(w0[bj][2]), "v"(w0[bj][3]));
                        if (mm > 0)
                            asm volatile("s_nop 1\n\t"
                                     "v_fmac_f32_dpp %0, %4, %8 row_shl:15 row_mask:0xf bank_mask:0xf bound_ctrl:1\n\tv_fmac_f32_dpp %1, %5, %9 row_shl:15 row_mask:0xf bank_mask:0xf bound_ctrl:1\n\t"
                                     "v_fmac_f32_dpp %2, %6, %10 row_shl:15 row_mask:0xf bank_mask:0xf bound_ctrl:1\n\tv_fmac_f32_dpp %3, %7, %11 row_shl:15 row_mask:0xf bank_mask:0xf bound_ctrl:1\n\t"
                                     "v_fmac_f32_dpp %0, %4, %12 row_shl:14 row_mask:0xf bank_mask:0xf bound_ctrl:1\n\tv_fmac_f32_dpp %1, %5, %13 row_shl:14 row_mask:0xf bank_mask:0xf bound_ctrl:1\n\t"
                                     "v_fmac_f32_dpp %2, %6, %14 row_shl:14 row_mask:0xf bank_mask:0xf bound_ctrl:1\n\tv_fmac_f32_dpp %3, %7, %15 row_shl:14 row_mask:0xf bank_mask:0xf bound_ctrl:1"
                                     : "+v"(c0), "+v"(c1), "+v"(c2), "+v"(c3)
                                     : "v"(prv[0]), "v"(prv[1]), "v"(prv[2]), "v"(prv[3]), "v"(w1[bj][0]), "v"(w1[bj][1]), "v"(w1[bj][2]), "v"(w1[bj][3]), "v"(w0[bj][0]), "v"(w0[bj][1]), "v"(w0[bj][2]), "v"(w0[bj][3]));
                        c[bj][0] = c0; c[bj][1] = c1; c[bj][2] = c2; c[bj][3] = c3; } }
                f32x4 a;
#pragma unroll
                for (int e = 0; e < 4; ++e) a[e] = c[1][e] * sigm(c[1][e]) * c[0][e];
                u32x2 w; w.x = cvt_pk_bf16(a[0], a[1]); w.y = cvt_pk_bf16(a[2], a[3]);
                if (mm > 0 || fr >= 2) *(u32x2*)(actb + mm * 1024 + 4 * n) = w;
            }
        }
    }
};
template <class Epi, class Sched, bool ALIGN_EPI = false, bool SP2 = false>
__device__ __forceinline__ void gemm_phase(PG8_LAS unsigned char* lds, const Gemm g, const Sched& S, const Epi& E) {
    const int tid = threadIdx.x, wid = __builtin_amdgcn_readfirstlane(tid >> 6), lane = tid & 63, wr = wid >> 2, wc = wid & 3, fr = lane & 15, fq = lane >> 4;
    const int nt = g.K / BK, K = g.ld ? g.ld : g.K;
    unsigned voffA[2], voffB[2];
#pragma unroll
    for (int i = 0; i < 2; ++i) { int R, C; stage_rc(tid * 16 + i * 8192, R, C); const int Rb = Epi::PERM ? ((R & ~31) + perm32(R & 31)) : R;
        voffA[i] = (unsigned)((128 * (R >> 6) + (R & 63)) * (g.ablk ? BK : K) + C) * 2u; voffB[i] = (unsigned)(Rb * (g.bblk ? BK : K) + C) * 2u; }
    const size_t kstep = (size_t)(BK * 2);
    const size_t hstep = (size_t)HALF * K * 2;
    const size_t hstepB = (size_t)HALF * (g.bblk ? BK : K) * 2;
    const size_t kstepB = g.bblk ? (size_t)256 * BK * 2 : kstep;
    const size_t hstepA = (size_t)64 * (g.ablk ? BK : K) * 2;
    const size_t kstepA = g.ablk ? (size_t)256 * BK * 2 : kstep;
    const size_t tstep = 2 * hstep;
    const unsigned ldsw = (unsigned)wid * 1024u;
    const int aoff = lds_byte(wr * 64 + fr, fq * 8), boff = lds_byte(wc * 32 + fr, fq * 8);
#define PG8_SA(b, h) (((b) * 2 + (h)) * HTB)
#define PG8_SB(b, h) ((4 + (b) * 2 + (h)) * HTB)
#define PG8_STAGE(bufoff, gbase, voff) do { _Pragma("unroll") for (int _i = 0; _i < 2; ++_i) \
        __builtin_amdgcn_global_load_lds((const unsigned*)((const char*)(gbase) + (voff)[_i]), (PG8_LAS unsigned*)(lds + (bufoff) + ldsw + _i * 8192), 16, 0, 0); } while (0)
#define PG8_LDA(dst, b, h) do { _Pragma("unroll") for (int m = 0; m < 4; ++m) _Pragma("unroll") for (int k = 0; k < 2; ++k) dst[m][k] = *(const PG8_LAS bf16x8*)(lds + PG8_SA(b, h) + aoff + m * 2048 + k * 1024); } while (0)
#define PG8_LDB(dst, b, h) do { _Pragma("unroll") for (int n = 0; n < 2; ++n) _Pragma("unroll") for (int k = 0; k < 2; ++k) dst[n][k] = *(const PG8_LAS bf16x8*)(lds + PG8_SB(b, h) + boff + n * 2048 + k * 1024); } while (0)
#define PG8_MMA(ai, bj, At, Bt) do { __builtin_amdgcn_s_setprio(1); _Pragma("unroll") for (int m = 0; m < 4; ++m) _Pragma("unroll") for (int n = 0; n < 2; ++n) _Pragma("unroll") for (int k = 0; k < 2; ++k) \
        acc[ai][bj][m][n] = __builtin_amdgcn_mfma_f32_16x16x32_bf16(Bt[n][k], At[m][k], acc[ai][bj][m][n], 0, 0, 0); __builtin_amdgcn_s_setprio(0); } while (0)
#define PG8_WAIT_V(n) asm volatile("s_waitcnt vmcnt(" #n ")" ::: "memory")
#define PG8_WAIT_L(n) asm volatile("s_waitcnt lgkmcnt(" #n ")" ::: "memory")
#define PG8_BAR __builtin_amdgcn_s_barrier()
#define PG8_SCHED __builtin_amdgcn_sched_barrier(0)
    Unit cur, nxt; int ui = 0;
    if (!S.next(0, cur)) return;
    f32x4 acc[2][2][4][2];
#pragma unroll
    for (int a = 0; a < 2; ++a)
#pragma unroll
        for (int b = 0; b < 2; ++b)
#pragma unroll
            for (int m = 0; m < 4; ++m)
#pragma unroll
                for (int n = 0; n < 2; ++n) acc[a][b][m][n] = (f32x4){0.f, 0.f, 0.f, 0.f};
    bf16x8 At[4][2], B0[2][2], B1[2][2];
    const char* cA = (const char*)g.A + (size_t)cur.pm * tstep; const char* cB = (const char*)g.Bt + (size_t)cur.pn * tstep;
    S.a_ready(cur);
    if constexpr (SP2) {
        PG8_STAGE(PG8_SB(0, 0), cB, voffB); PG8_STAGE(PG8_SB(0, 1), cB + hstepB, voffB); PG8_STAGE(PG8_SA(0, 0), cA, voffA); PG8_STAGE(PG8_SA(0, 1), cA + hstepA, voffA);
        if (wr == 1) PG8_BAR;
        PG8_WAIT_V(2); PG8_BAR;
        PG8_STAGE(PG8_SB(1, 0), cB + kstepB, voffB); PG8_STAGE(PG8_SA(1, 0), cA + kstepA, voffA); PG8_STAGE(PG8_SB(1, 1), cB + hstepB + kstepB, voffB);
        PG8_WAIT_V(6); PG8_BAR;
    } else {
        PG8_STAGE(PG8_SB(0, 0), cB, voffB); PG8_STAGE(PG8_SA(0, 0), cA, voffA); PG8_STAGE(PG8_SB(0, 1), cB + hstepB, voffB); PG8_STAGE(PG8_SA(0, 1), cA + hstepA, voffA);
        if (wr == 1) PG8_BAR;
        PG8_WAIT_V(4); PG8_BAR;
        PG8_STAGE(PG8_SB(1, 0), cB + kstepB, voffB); PG8_STAGE(PG8_SA(1, 0), cA + kstepA, voffA); PG8_STAGE(PG8_SB(1, 1), cB + hstepB + kstepB, voffB);
        PG8_WAIT_V(6); PG8_BAR;
    }
    for (;;) {
        const bool has_next = S.next(ui + 1, nxt);
        const char* nA = has_next ? (const char*)g.A + (size_t)nxt.pm * tstep : cA; const char* nB = has_next ? (const char*)g.Bt + (size_t)nxt.pn * tstep : cB;
        for (int t = 0; t < nt; t += 2) {
            const bool last = (t == nt - 2);
            const char* a1 = cA + (size_t)(t + 1) * kstepA;
            const char* a2 = last ? nA : cA + (size_t)(t + 2) * kstepA; const char* b2 = last ? nB : cB + (size_t)(t + 2) * kstepB;
            const char* a3 = a2 + kstepA; const char* b3 = b2 + kstepB;
            if (last && has_next) S.a_ready(nxt);
            if constexpr (SP2) {
            PG8_LDB(B0, 0, 0); PG8_LDB(B1, 0, 1); PG8_SCHED; PG8_LDA(At, 0, 0); PG8_STAGE(PG8_SA(1, 1), a1 + hstepA, voffA);
            PG8_WAIT_V(8); PG8_WAIT_L(0); PG8_BAR; PG8_MMA(0, 0, At, B0); PG8_MMA(0, 1, At, B1); PG8_BAR; PG8_SCHED;
            PG8_LDA(At, 0, 1); PG8_STAGE(PG8_SB(0, 0), b2, voffB); PG8_STAGE(PG8_SB(0, 1), b2 + hstepB, voffB); PG8_STAGE(PG8_SA(0, 0), a2, voffA);
            PG8_WAIT_V(8); PG8_WAIT_L(0); PG8_BAR; PG8_MMA(1, 0, At, B0); PG8_MMA(1, 1, At, B1); PG8_BAR; PG8_SCHED;
            PG8_LDB(B0, 1, 0); PG8_LDB(B1, 1, 1); PG8_SCHED; PG8_LDA(At, 1, 0); PG8_STAGE(PG8_SA(0, 1), a2 + hstepA, voffA);
            PG8_WAIT_V(8); PG8_WAIT_L(0); PG8_BAR; PG8_MMA(0, 0, At, B0); PG8_MMA(0, 1, At, B1); PG8_BAR; PG8_SCHED;
            PG8_LDA(At, 1, 1); PG8_STAGE(PG8_SB(1, 0), b3, voffB); PG8_STAGE(PG8_SB(1, 1), b3 + hstepB, voffB); PG8_STAGE(PG8_SA(1, 0), a3, voffA);
            PG8_WAIT_V(8); PG8_WAIT_L(0); PG8_BAR; PG8_MMA(1, 0, At, B0); PG8_MMA(1, 1, At, B1); PG8_BAR; PG8_SCHED;
            } else {
            PG8_LDB(B0, 0, 0); PG8_SCHED; PG8_LDA(At, 0, 0); PG8_STAGE(PG8_SA(1, 1), a1 + hstepA, voffA);
            PG8_WAIT_L(8); PG8_BAR; PG8_WAIT_L(0); PG8_MMA(0, 0, At, B0); PG8_BAR; PG8_SCHED;
            PG8_LDB(B1, 0, 1); PG8_STAGE(PG8_SB(0, 0), b2, voffB);
            PG8_BAR; PG8_WAIT_L(0); PG8_MMA(0, 1, At, B1); PG8_BAR;
            PG8_LDA(At, 0, 1); PG8_STAGE(PG8_SA(0, 0), a2, voffA);
            PG8_BAR; PG8_WAIT_L(0); PG8_MMA(1, 0, At, B0); PG8_BAR; PG8_SCHED;
            PG8_STAGE(PG8_SB(0, 1), b2 + hstepB, voffB);
            PG8_WAIT_V(6); PG8_BAR; PG8_MMA(1, 1, At, B1); PG8_BAR;
            PG8_LDB(B0, 1, 0); PG8_SCHED; PG8_LDA(At, 1, 0); PG8_STAGE(PG8_SA(0, 1), a2 + hstepA, voffA);
            PG8_WAIT_L(8); PG8_BAR; PG8_WAIT_L(0); PG8_MMA(0, 0, At, B0); PG8_BAR; PG8_SCHED;
            PG8_LDB(B1, 1, 1); PG8_STAGE(PG8_SB(1, 0), b3, voffB);
            PG8_BAR; PG8_WAIT_L(0); PG8_MMA(0, 1, At, B1); PG8_BAR;
            PG8_LDA(At, 1, 1); PG8_STAGE(PG8_SA(1, 0), a3, voffA);
            PG8_BAR; PG8_WAIT_L(0); PG8_MMA(1, 0, At, B0); PG8_BAR; PG8_SCHED;
            PG8_STAGE(PG8_SB(1, 1), b3 + hstepB, voffB);
            PG8_WAIT_V(6); PG8_BAR; PG8_MMA(1, 1, At, B1); PG8_BAR;
            }
        }
        if constexpr (ALIGN_EPI) { if (wr == 0) PG8_BAR; }
        if constexpr (!Epi::AFTER_DRAIN) { E(acc, cur, wr, wc, fr, fq); S.done(cur); }
        if (!has_next) break;
#pragma unroll
        for (int a = 0; a < 2; ++a)
#pragma unroll
            for (int b = 0; b < 2; ++b)
#pragma unroll
                for (int m = 0; m < 4; ++m)
#pragma unroll
                    for (int n = 0; n < 2; ++n) acc[a][b][m][n] = (f32x4){0.f, 0.f, 0.f, 0.f};
        cur = nxt; cA = nA; cB = nB; ++ui;
        if constexpr (ALIGN_EPI) { if (wr == 1) PG8_BAR; }
    }
    PG8_WAIT_V(0);
    if constexpr (!ALIGN_EPI) { if (wr == 0) PG8_BAR; }
    PG8_BAR;
    if constexpr (Epi::AFTER_DRAIN) { E.fused(acc, cur, wr, wc, fr, fq, lds, wid, lane); S.done(cur); }
#undef PG8_SA
#undef PG8_SB
#undef PG8_STAGE
#undef PG8_LDA
#undef PG8_LDB
#undef PG8_MMA
#undef PG8_WAIT_V
#undef PG8_WAIT_L
#undef PG8_BAR
#undef PG8_SCHED
}
}
#ifndef PG8_SP2
#define PG8_SP2 true
#endif
#ifndef PG8_ALIGN
#define PG8_ALIGN true
#endif

struct Args {
    const float* in[31]; float* out; unsigned char* ws;
    int ph_lo, ph_hi;
};
enum InIdx { I_X = 0, I_ANG, I_WIN, I_RELB, I_QNG, I_KNG, I_PEK, I_W1K, I_W2K, I_PEV, I_W1V, I_W2V, I_MU, I_W0, I_W2, I_A0, I_A2, I_G2, I_KK, I_KA, I_RK, I_LNG, I_LNB,
             I_WPA, I_WPB, I_WOUT, I_FNG, I_WUP, I_CW, I_CB, I_WDN };

#define LDS_WAIT() asm volatile("s_waitcnt lgkmcnt(0)" ::: "memory")
#define VM_WAIT() asm volatile("s_waitcnt vmcnt(0)" ::: "memory")

__device__ __forceinline__ int srccol(int mode, int nd) {
    if (mode == 1) {
        if (nd < 1280) { const int t = nd >> 8, p = nd & 255; return 256 * t + 64 * ((p >> 5) & 3) + 32 * (p >> 7) + (p & 31); }
        if (nd < 5120) return nd + 24; if (nd < 5144) return 1280 + (nd - 5120); return -1; }
    if (mode == 2) {
        const int pn = nd >> 8, r = nd & 255; return (r >> 7) * 2816 + pn * 128 + (r & 127); }
    return nd;
}
__device__ __forceinline__ void tr_item(const float* W, int Nsrc, bf16_t* WT, int K, LAS float* scr, int kb, int nb, int lane, int mode, const float* rscale = nullptr, bool blocked = false, float gsc = 1.f) {
    const int k0 = 64 * kb, n0 = 32 * nb; const int sc = srccol(mode, n0 + (lane & 31));
    const int scc = sc >= 0 ? sc : 0; const float* wp = W + (size_t)(k0 + (lane >> 5)) * Nsrc + scc; float v[32];
#pragma unroll
    for (int i = 0; i < 32; ++i) v[i] = wp[(size_t)(2 * i) * Nsrc];
    if (rscale) { const float* rp = rscale + k0 + (lane >> 5); float rs[32];
#pragma unroll
        for (int i = 0; i < 32; ++i) rs[i] = rp[2 * i];
#pragma unroll
        for (int i = 0; i < 32; ++i) v[i] *= rs[i]; }
#pragma unroll
    for (int i = 0; i < 32; ++i) scr[(2 * i + (lane >> 5)) * 33 + (lane & 31)] = sc >= 0 ? v[i] * gsc : 0.f;
    LDS_WAIT(); asm volatile("" ::: "memory");
    const int c = lane & 7;
#pragma unroll
    for (int j = 0; j < 4; ++j) { const int n = (lane >> 3) + 8 * j; const LAS float* s = scr + (8 * c) * 33 + n;
        u32x4 o; o.x = pk2(s[0 * 33], s[1 * 33]); o.y = pk2(s[2 * 33], s[3 * 33]); o.z = pk2(s[4 * 33], s[5 * 33]); o.w = pk2(s[6 * 33], s[7 * 33]);
        if (blocked) *(u32x4*)(WT + ((size_t)((n0 + n) >> 8) * (K >> 6) + kb) * 16384 + ((n0 + n) & 255) * 64 + 8 * c) = o;
        else *(u32x4*)(WT + (size_t)(n0 + n) * K + k0 + 8 * c) = o; }
    LDS_WAIT(); asm volatile("" ::: "memory");
}
__device__ __forceinline__ void rms_rows2_to_bf16(const float* x0, const float* x1, const float* g, bf16_t* o0, bf16_t* o1, int lane) {
    const f32x4* xa = (const f32x4*)x0 + lane; const f32x4* xb = (const f32x4*)x1 + lane; const f32x4* gr = (const f32x4*)g + lane;
    f32x4 va[4], vb[4]; float sa = 0.f, sb = 0.f;
#pragma unroll
    for (int j = 0; j < 4; ++j) { va[j] = xa[64 * j]; vb[j] = xb[64 * j]; }
#pragma unroll
    for (int j = 0; j < 4; ++j) { sa += (va[j].x * va[j].x + va[j].y * va[j].y) + (va[j].z * va[j].z + va[j].w * va[j].w); sb += (vb[j].x * vb[j].x + vb[j].y * vb[j].y) + (vb[j].z * vb[j].z + vb[j].w * vb[j].w); }
    const float ra = rsqrtf(wave_sum(sa) * (1.f / 1024.f) + RMS_EPS), rb = rsqrtf(wave_sum(sb) * (1.f / 1024.f) + RMS_EPS);
    unsigned long long* oa = (unsigned long long*)o0 + lane; unsigned long long* ob = (unsigned long long*)o1 + lane;
#pragma unroll
    for (int j = 0; j < 4; ++j) { const f32x4 gg = gr[64 * j];
        oa[64 * j] = (unsigned long long)pk2(va[j].x * ra * gg.x, va[j].y * ra * gg.y) | ((unsigned long long)pk2(va[j].z * ra * gg.z, va[j].w * ra * gg.w) << 32);
        ob[64 * j] = (unsigned long long)pk2(vb[j].x * rb * gg.x, vb[j].y * rb * gg.y) | ((unsigned long long)pk2(vb[j].z * rb * gg.z, vb[j].w * rb * gg.w) << 32); }
}
__device__ __forceinline__ void prologue_early_items(const Args& a, LAS float* scr, int gw, int NGW, int lane) {
    constexpr int I0 = 16 * 168, I6 = 32 * 8, I7 = 32 * 8; constexpr int NITEMS = I0 + I6 + I7 + 64 + 16;
    unsigned char* ws = a.ws;
    for (int it = gw; it < NITEMS; it += NGW) {
        int r = it;
        if (r < I0) { tr_item(a.in[I_WIN], 5144, (bf16_t*)(ws + WS_WIN), 1024, scr, r / 168, r % 168, lane, 1); continue; } r -= I0;
        if (r < I6) { tr_item(a.in[I_W1K], 256, (bf16_t*)(ws + WS_WC1K), 2048, scr, r / 8, r % 8, lane, 0); continue; } r -= I6;
        if (r < I7) { tr_item(a.in[I_W1V], 256, (bf16_t*)(ws + WS_WC1V), 2048, scr, r / 8, r % 8, lane, 0); continue; } r -= I7;
        if (r >= 64) { const int q = r - 64;
            tr_item(a.in[q < 8 ? I_W2K : I_W2V], 64, (bf16_t*)(ws + WS_WC2T + (q < 8 ? 0 : 32768)), 256, scr, (q & 7) >> 1, q & 1, lane, 0); continue; }
        if (r < 16) tr_item(a.in[I_W2], 512, (bf16_t*)(ws + 38 * MiB), 64, scr, 0, r, lane, 0);
        else if (r < 32) tr_item(a.in[I_A2], 512, (bf16_t*)(ws + 38 * MiB + 65536), 64, scr, 0, r - 16, lane, 0);
        else tr_item(a.in[I_G2], 512, (bf16_t*)(ws + 38 * MiB + 131072), 128, scr, (r - 32) / 16, (r - 32) % 16, lane, 0);
    }
}
__device__ __forceinline__ void prologue_late_items(const Args& a, LAS float* scr, int gw, int NGW, int lane) {
    constexpr int I1 = 8 * 32, I2 = 8 * 32, I3 = 16 * 32, I4 = 16 * 176, I5 = 44 * 32; constexpr int NITEMS = I1 + I2 + I3 + I4 + I5;
    unsigned char* ws = a.ws;
    for (int it = gw; it < NITEMS; it += NGW) {
        int r = it;
        if (r < I1) { tr_item(a.in[I_WPA], 1024, (bf16_t*)(ws + WS_WPA), 512, scr, r / 32, r % 32, lane, 0, nullptr, false, 1.f / 255.f); continue; }     r -= I1;
        if (r < I2) { tr_item(a.in[I_WPB], 1024, (bf16_t*)(ws + WS_WPB), 512, scr, r / 32, r % 32, lane, 0, nullptr, false, 1.f / 255.f); continue; } r -= I2;
        if (r < I3) { tr_item(a.in[I_WOUT], 1024, (bf16_t*)(ws + WS_WOUT), 1024, scr, r / 32, r % 32, lane, 0); continue; } r -= I3;
        if (r < I4) { tr_item(a.in[I_WUP], 5632, (bf16_t*)(ws + WS_WUP), 1024, scr, r / 176, r % 176, lane, 2, a.in[I_FNG]); continue; } r -= I4;
        tr_item(a.in[I_WDN], 1024, (bf16_t*)(ws + WS_WDN), 2816, scr, r / 32, r % 32, lane, 0, nullptr, true);
    }
}
__device__ __forceinline__ void phase_prologue(const Args& a, LAS unsigned char* lds, int bid, int nb) {
    const int tid = threadIdx.x, lane = tid & 63, wave = tid >> 6;
    LAS float* scr = (LAS float*)(lds + wave * 16384);
    const int gw = bid * 8 + wave, NGW = nb * 8;
    prologue_early_items(a, scr, gw, NGW, lane);
    bf16_t* H = (bf16_t*)(a.ws + WS_H);
    for (int m = 4 * gw; m < NT; m += 4 * NGW) {
        rms_rows2_to_bf16(a.in[I_X] + (size_t)m * 1024, a.in[I_X] + (size_t)(m + 1) * 1024, a.in[I_ANG], H + (size_t)m * 1024, H + (size_t)(m + 1) * 1024, lane);
        rms_rows2_to_bf16(a.in[I_X] + (size_t)(m + 2) * 1024, a.in[I_X] + (size_t)(m + 3) * 1024, a.in[I_ANG], H + (size_t)(m + 2) * 1024, H + (size_t)(m + 3) * 1024, lane); }
}
__device__ __forceinline__ void gates_items(const Args& a, int gw, int NGW, int lane) {
    const int r32 = lane & 31, hi = lane >> 5;
    const bf16_t* H = (const bf16_t*)(a.ws + WS_H); const bf16_t* WG = (const bf16_t*)(a.ws + WS_WIN) + (size_t)(5120 + r32) * 1024 + 8 * hi; float* GT = (float*)(a.ws + WS_GT);
    for (int grp = gw; grp < NT / 32; grp += NGW) {
        const size_t m = (size_t)grp * 32 + r32; const bf16_t* hp = H + m * 1024 + 8 * hi;
        f32x16 acc = (f32x16){0.f, 0.f, 0.f, 0.f, 0.f, 0.f, 0.f, 0.f, 0.f, 0.f, 0.f, 0.f, 0.f, 0.f, 0.f, 0.f};
#pragma unroll 8
        for (int ks = 0; ks < 64; ++ks) acc = __builtin_amdgcn_mfma_f32_32x32x16_bf16(*(const bf16x8*)(WG + 16 * ks), *(const bf16x8*)(hp + 16 * ks), acc, 0, 0, 0);
#pragma unroll
        for (int q = 0; q < 3; ++q) *(f32x4*)(GT + m * 24 + 8 * q + 4 * hi) = (f32x4){sigmoidf_(acc[4 * q]), sigmoidf_(acc[4 * q + 1]), sigmoidf_(acc[4 * q + 2]), sigmoidf_(acc[4 * q + 3])};
    }
}
namespace att {
constexpr int SLOTB = 8192;
constexpr int L_BT = 0  , L_WS = 4096  , L_SEL = 6144  , L_FLG = 6656  , L_K = 8192, NSTG = 4  , L_V = L_K + NSTG * SLOTB, L_END = L_V + NSTG * SLOTB;
constexpr int C_K = 8192  , C_V = C_K + 4 * SLOTB, C_IMP = C_V + 4 * SLOTB  , IMPP = 260, C_END = C_IMP + 64 * IMPP * 4, C_BT = C_END  , C_GT = C_BT + 2048  , C_END2 = C_GT + 3072;
static_assert(C_END2 <= LDS_BYTES - 256, "cmp LDS");
__device__ __forceinline__ int crow(int r, int hi) { return (r & 3) + 8 * (r >> 2) + 4 * hi; }
__device__ __forceinline__ unsigned cvtpk(float lo, float hi) { typedef float f2_ __attribute__((ext_vector_type(2))); typedef __bf16 b2_ __attribute__((ext_vector_type(2))); const f2_ v = {lo, hi}; const b2_ b = __builtin_convertvector(v, b2_); return __builtin_bit_cast(unsigned, b); }
__device__ __forceinline__ void glds16(const void* gsrc, LAS unsigned char* dst) {
    __builtin_amdgcn_global_load_lds((const unsigned*)gsrc, (LAS unsigned*)dst, 16, 0, 0);
}
__device__ __forceinline__ void qkt(f32x16& p0, f32x16& p1, const LAS unsigned char* Kslot, const bf16x8* qr, int r32, int hi) {
    const LAS unsigned char* kb = Kslot + hi * 1024 + r32 * 16;
    p0 = (f32x16){0.f, 0.f, 0.f, 0.f, 0.f, 0.f, 0.f, 0.f, 0.f, 0.f, 0.f, 0.f, 0.f, 0.f, 0.f, 0.f}; p1 = p0;
    bf16x8 kf[4][2];
#pragma unroll
    for (int d0 = 0; d0 < 4; ++d0) { kf[d0][0] = *(const LAS bf16x8*)(kb + d0 * 2048); kf[d0][1] = *(const LAS bf16x8*)(kb + d0 * 2048 + 512); }
    __builtin_amdgcn_sched_barrier(0);
#pragma unroll
    for (int d0 = 0; d0 < 4; ++d0) {
        p0 = __builtin_amdgcn_mfma_f32_32x32x16_bf16(kf[d0][0], qr[d0], p0, 0, 0, 0);
        p1 = __builtin_amdgcn_mfma_f32_32x32x16_bf16(kf[d0][1], qr[d0], p1, 0, 0, 0);
    }
}
typedef short v4i16_t __attribute__((ext_vector_type(4)));
__device__ __forceinline__ s16x4 vtr(const LAS unsigned char* p) { return __builtin_bit_cast(s16x4, __builtin_amdgcn_ds_read_tr16_b64_v4i16((LAS v4i16_t*)p)); }
__device__ __forceinline__ void pv(f32x16* o, const LAS unsigned char* vp, bf16x8 pa0, bf16x8 pa1, bf16x8 pa2, bf16x8 pa3) {
    s16x4 lo[2][4], hi[2][4];
#pragma unroll
    for (int d0 = 0; d0 < 2; ++d0)
#pragma unroll
        for (int ks = 0; ks < 4; ++ks) { lo[d0][ks] = vtr(vp + d0 * 4096 + ks * 1024); hi[d0][ks] = vtr(vp + d0 * 4096 + ks * 1024 + 512); }
    __builtin_amdgcn_sched_barrier(0);
#define PK(d, k) (bf16x8){lo[d][k][0], lo[d][k][1], lo[d][k][2], lo[d][k][3], hi[d][k][0], hi[d][k][1], hi[d][k][2], hi[d][k][3]}
    o[0] = __builtin_amdgcn_mfma_f32_32x32x16_bf16(pa0, PK(0, 0), o[0], 0, 0, 0); o[1] = __builtin_amdgcn_mfma_f32_32x32x16_bf16(pa0, PK(1, 0), o[1], 0, 0, 0);
    o[0] = __builtin_amdgcn_mfma_f32_32x32x16_bf16(pa1, PK(0, 1), o[0], 0, 0, 0); o[1] = __builtin_amdgcn_mfma_f32_32x32x16_bf16(pa1, PK(1, 1), o[1], 0, 0, 0);
    o[0] = __builtin_amdgcn_mfma_f32_32x32x16_bf16(pa2, PK(0, 2), o[0], 0, 0, 0); o[1] = __builtin_amdgcn_mfma_f32_32x32x16_bf16(pa2, PK(1, 2), o[1], 0, 0, 0);
    o[0] = __builtin_amdgcn_mfma_f32_32x32x16_bf16(pa3, PK(0, 3), o[0], 0, 0, 0); o[1] = __builtin_amdgcn_mfma_f32_32x32x16_bf16(pa3, PK(1, 3), o[1], 0, 0, 0);
#undef PK
}
__device__ __forceinline__ void qkt_c(f32x16& p0, f32x16& p1, const LAS unsigned char* Kslot, const bf16x8* qr, const f32x16& cin, int r32, int hi) {
    const LAS unsigned char* kb = Kslot + hi * 1024 + r32 * 16;
#pragma unroll
    for (int d0 = 0; d0 < 4; ++d0) {
        const bf16x8 b0 = *(const LAS bf16x8*)(kb + d0 * 2048);
        const bf16x8 b1 = *(const LAS bf16x8*)(kb + d0 * 2048 + 512);
        if (d0 == 0) { p0 = __builtin_amdgcn_mfma_f32_32x32x16_bf16(b0, qr[0], cin, 0, 0, 0); p1 = __builtin_amdgcn_mfma_f32_32x32x16_bf16(b1, qr[0], cin, 0, 0, 0); }
        else { p0 = __builtin_amdgcn_mfma_f32_32x32x16_bf16(b0, qr[d0], p0, 0, 0, 0); p1 = __builtin_amdgcn_mfma_f32_32x32x16_bf16(b1, qr[d0], p1, 0, 0, 0); }
    }
}
__device__ __forceinline__ void qkt_acc(f32x16& p0, f32x16& p1, const LAS unsigned char* Kslot, const bf16x8* qr, int r32, int hi) {
    const LAS unsigned char* kb = Kslot + hi * 1024 + r32 * 16;
    bf16x8 kf[4][2];
#pragma unroll
    for (int d0 = 0; d0 < 4; ++d0) { kf[d0][0] = *(const LAS bf16x8*)(kb + d0 * 2048); kf[d0][1] = *(const LAS bf16x8*)(kb + d0 * 2048 + 512); }
    __builtin_amdgcn_sched_barrier(0);
#pragma unroll
    for (int d0 = 0; d0 < 4; ++d0) {
        p0 = __builtin_amdgcn_mfma_f32_32x32x16_bf16(kf[d0][0], qr[d0], p0, 0, 0, 0);
        p1 = __builtin_amdgcn_mfma_f32_32x32x16_bf16(kf[d0][1], qr[d0], p1, 0, 0, 0);
    }
}
template <int MODE>
__device__ __forceinline__ void branch(f32x16 (&o)[2], LAS unsigned char* shm, const bf16x8 (&qr)[4], const bf16_t* Kg  , const bf16_t* Vg  ,
                                       int qb, unsigned long long sel, float bfar  , int wid, int lane) {
    const int r32 = lane & 31, hi = lane >> 5, th = wid & 1, hr = wid >> 1;
    const int tq = 32 * th + r32;
    const int j0 = MODE == 0 ? 0 : (qb >= 8 ? qb - 8 : 0), nt = qb - j0 + 1;
    LAS float* wsf = (LAS float*)(shm + L_WS) + wid * 64;
    const LAS float* bt = (const LAS float*)(shm + L_BT) + hr * 256;
    const bf16_t* ksrc = Kg + (size_t)lane * 128 + wid * 8;
    const bf16_t* vsrc = Vg + (size_t)(16 * (wid & 3) + (lane >> 2)) * 128 + (wid >> 2) * 32 + (lane & 3) * 8;
    const LAS unsigned char* vp0 = shm + L_V + ((lane >> 4) & 1) * 32 + (lane & 3) * 8 + (4 * hi + ((lane & 15) >> 2)) * 64;
    o[0] = (f32x16){0.f, 0.f, 0.f, 0.f, 0.f, 0.f, 0.f, 0.f, 0.f, 0.f, 0.f, 0.f, 0.f, 0.f, 0.f, 0.f}; o[1] = o[0];
    float M = 0.f, lsum = 0.f;
    bool scaled = false;
#define DMA_TILE(ii) do { const int s_ = ((ii) & (NSTG - 1)) * SLOTB; glds16(ksrc + (size_t)(64 * (j0 + (ii))) * 128, shm + L_K + s_ + wid * 1024); glds16(vsrc + (size_t)(64 * (j0 + (ii))) * 128, shm + L_V + s_ + wid * 1024); } while (0)
#define SCORE(P0, P1, ii) qkt(P0, P1, shm + L_K + ((ii) & (NSTG - 1)) * SLOTB, qr, r32, hi)
#define FINISH(P0, P1, ii) do { const int j = j0 + (ii), dq = qb - j; const bool far = dq >= 3; \
        bool rowsel = true; if (MODE == 0) rowsel = (sel >> j) & 1ull; \
        if (!far) { \
            if (!scaled) { const float fb = __builtin_amdgcn_exp2f(bfar); lsum *= fb; _Pragma("unroll") for (int r = 0; r < 16; ++r) { o[0][r] *= fb; o[1][r] *= fb; } scaled = true; } \
        } else if (MODE == 1 && dq == 8) {                             \
            _Pragma("unroll") for (int r = 0; r < 16; ++r) { const int d0 = 512 + tq - crow(r, hi), d1 = d0 - 32; P0[r] = d0 < 512 ? P0[r] : -INFINITY; P1[r] = d1 < 512 ? P1[r] : -INFINITY; } } \
        if (__any(M != 0.f)) { _Pragma("unroll") for (int r = 0; r < 16; ++r) { P0[r] -= M; P1[r] -= M; } }     \
        float sm = 0.f; \
        _Pragma("unroll") for (int r = 0; r < 16; ++r) { P0[r] = __builtin_amdgcn_exp2f(P0[r]); P1[r] = __builtin_amdgcn_exp2f(P1[r]); sm += P0[r] + P1[r]; } \
        u32x4 pw0, pw1, pw2, pw3; \
        pw0 = (u32x4){cvtpk(P0[0], P0[1]), cvtpk(P0[2], P0[3]), cvtpk(P0[4], P0[5]), cvtpk(P0[6], P0[7])}; \
        pw1 = (u32x4){cvtpk(P0[8], P0[9]), cvtpk(P0[10], P0[11]), cvtpk(P0[12], P0[13]), cvtpk(P0[14], P0[15])}; \
        pw2 = (u32x4){cvtpk(P1[0], P1[1]), cvtpk(P1[2], P1[3]), cvtpk(P1[4], P1[5]), cvtpk(P1[6], P1[7])}; \
        pw3 = (u32x4){cvtpk(P1[8], P1[9]), cvtpk(P1[10], P1[11]), cvtpk(P1[12], P1[13]), cvtpk(P1[14], P1[15])}; \
        if (MODE == 0 && !__all(rowsel)) { const unsigned mk = rowsel ? 0xffffffffu : 0u; pw0 &= mk; pw1 &= mk; pw2 &= mk; pw3 &= mk; sm = rowsel ? sm : 0.f; } \
        lsum += sm; \
        pv(o, vp0 + ((ii) & (NSTG - 1)) * SLOTB, __builtin_bit_cast(bf16x8, pw0), __builtin_bit_cast(bf16x8, pw1), __builtin_bit_cast(bf16x8, pw2), __builtin_bit_cast(bf16x8, pw3)); \
        if (__any(sm > 1.0e12f)) {                                     \
            float big = fmaxf(sm, __shfl_xor(sm, 32)); const float dl = big > 1.0f ? floorf(__builtin_amdgcn_logf(big)) : 0.f; const float f = __builtin_amdgcn_exp2f(-dl); M += dl; \
            lsum *= f; if (hi == 0) wsf[r32] = f; LDS_WAIT(); asm volatile("" ::: "memory"); \
            _Pragma("unroll") for (int r = 0; r < 16; ++r) { const float fr = wsf[crow(r, hi)]; o[0][r] *= fr; o[1][r] *= fr; } \
            LDS_WAIT(); asm volatile("" ::: "memory"); } } while (0)
#define TILE(ii) do { f32x16 p0, p1; \
        if (qb - (j0 + (ii)) < 3) {                                     \
            const LAS float* bl = bt + (191 - 64 * (qb - (j0 + (ii))) - tq + 4 * hi); \
            _Pragma("unroll") for (int r = 0; r < 16; ++r) { p0[r] = bl[(r & 3) + 8 * (r >> 2)]; p1[r] = bl[32 + (r & 3) + 8 * (r >> 2)]; } \
            qkt_acc(p0, p1, shm + L_K + ((ii) & (NSTG - 1)) * SLOTB, qr, r32, hi); \
        } else SCORE(p0, p1, ii); \
        FINISH(p0, p1, ii); } while (0)
    DMA_TILE(0); if (nt > 1) DMA_TILE(1);
    for (int i = 0; i < nt; i += 2) {
        asm volatile("s_waitcnt vmcnt(0)" ::: "memory");
        __builtin_amdgcn_s_barrier(); asm volatile("" ::: "memory");
        if (i + 2 < nt) DMA_TILE(i + 2);
        if (i + 3 < nt) DMA_TILE(i + 3);
        TILE(i);
        if (i + 1 < nt) TILE(i + 1);
    }
#undef TILE
#undef STEP
#undef FINISH
#undef SCORE
#undef DMA_TILE
    lsum += __shfl_xor(lsum, 32);
    if (hi == 0) wsf[32 + r32] = lsum;
    LDS_WAIT(); asm volatile("" ::: "memory");
#pragma unroll
    for (int r = 0; r < 16; ++r) { const float li = __builtin_amdgcn_rcpf(fmaxf(wsf[32 + crow(r, hi)], 1e-30f)); o[0][r] *= li; o[1][r] *= li; }
    LDS_WAIT(); asm volatile("" ::: "memory");
    __syncthreads();
}
__device__ __forceinline__ void cmp_branch(f32x16 (&o)[2], LAS unsigned char* shm, const bf16x8 (&qr)[4], const bf16_t* Kg, const bf16_t* Vg, int qb, float bfar, int wid, int lane) {
    const int r32 = lane & 31, hi = lane >> 5, th = wid & 1, hr = wid >> 1, tid = threadIdx.x;
    const int tq = 32 * th + r32;
    const int nkt = (4 * qb + 3 + 63) >> 6;
    LAS float* wsf = (LAS float*)(shm + L_WS) + wid * 64;
    const LAS float* bt = (const LAS float*)(shm + L_BT) + hr * 256;
    LAS unsigned* imp = (LAS unsigned*)(shm + C_IMP);
    const LAS float* btc = (const LAS float*)(shm + C_BT) + hr * 128 + 1;
    const bf16_t* ksrc = Kg + (size_t)lane * 64 + wid * 8;
    const bf16_t* vsrc = Vg + (size_t)(16 * (wid & 3) + (lane >> 2)) * 64 + (wid >> 2) * 32 + (lane & 3) * 8;
    const LAS unsigned char* vp0 = shm + C_V + ((lane >> 4) & 1) * 32 + (lane & 3) * 8 + (4 * hi + ((lane & 15) >> 2)) * 64;
    for (int kt = 0; kt < nkt; ++kt) { glds16(ksrc + (size_t)(64 * kt) * 64, shm + C_K + kt * SLOTB + wid * 1024); glds16(vsrc + (size_t)(64 * kt) * 64, shm + C_V + kt * SLOTB + wid * 1024); }
    for (int e = tid; e < 64 * IMPP; e += 512) imp[e] = 0u;
    o[0] = (f32x16){0.f, 0.f, 0.f, 0.f, 0.f, 0.f, 0.f, 0.f, 0.f, 0.f, 0.f, 0.f, 0.f, 0.f, 0.f, 0.f}; o[1] = o[0];
    VM_WAIT(); __syncthreads();
    float mrun = -1e30f, lrun = 0.f;
#define CMP_SCORES(kt) \
        f32x16 p0, p1; \
        if (64 * qb - 31 - 1024 * (kt) - 1008 >= 113) qkt(p0, p1, shm + C_K + (kt) * SLOTB, qr, r32, hi);     \
        else { const int dl = 64 * qb + tq - 31 - 1024 * (kt) - 64 * hi; \
            _Pragma("unroll") for (int r = 0; r < 16; ++r) { const int d0 = dl - 16 * ((r & 3) + 8 * (r >> 2)), d1 = d0 - 512; \
                p0[r] = btc[min(max(d0, -1), 113)]; p1[r] = btc[min(max(d1, -1), 113)]; } \
            qkt_acc(p0, p1, shm + C_K + (kt) * SLOTB, qr, r32, hi); }
    for (int kt = 0; kt < nkt; ++kt) {
        CMP_SCORES(kt)
        float sm = 0.f;
#pragma unroll
        for (int r = 0; r < 16; ++r) sm += __builtin_amdgcn_exp2f(p0[r]) + __builtin_amdgcn_exp2f(p1[r]);
        lrun += sm;
    }
    lrun += __shfl_xor(lrun, 32); mrun = 0.f;
    if (__any(!(lrun < 1.0e30f) || (lrun < 1.0e-30f && 64 * qb + tq >= 31))) {
    mrun = -1e30f; lrun = 0.f;
    for (int kt = 0; kt < nkt; ++kt) {
        CMP_SCORES(kt)
        float mx = mrun;
#pragma unroll
        for (int r = 0; r < 16; ++r) mx = fmaxf(mx, fmaxf(p0[r], p1[r]));
        mx = fmaxf(mx, __shfl_xor(mx, 32));
        float sm = 0.f;
#pragma unroll
        for (int r = 0; r < 16; ++r) sm += __builtin_amdgcn_exp2f(p0[r] - mx) + __builtin_amdgcn_exp2f(p1[r] - mx);
        sm += __shfl_xor(sm, 32);
        lrun = lrun * __builtin_amdgcn_exp2f(mrun - mx) + sm; mrun = mx;
    }
    }
    const float invl = 1.0f / fmaxf(lrun, 1e-30f), invf = invl * 67108864.0f;
    const bool shifted = __any(mrun != 0.f);
    for (int kt = 0; kt < nkt; ++kt) {
        CMP_SCORES(kt)
#pragma unroll
        for (int r = 0; r < 16; ++r) { p0[r] = __builtin_amdgcn_exp2f(shifted ? p0[r] - mrun : p0[r]); p1[r] = __builtin_amdgcn_exp2f(shifted ? p1[r] - mrun : p1[r]); }
        LAS unsigned* ir = imp + tq * IMPP + 64 * kt;
#pragma unroll
        for (int r = 0; r < 16; ++r) { __hip_atomic_fetch_add(ir + crow(r, hi), (unsigned)(p0[r] * invf + 0.5f), __ATOMIC_RELAXED, __HIP_MEMORY_SCOPE_WORKGROUP); __hip_atomic_fetch_add(ir + 32 + crow(r, hi), (unsigned)(p1[r] * invf + 0.5f), __ATOMIC_RELAXED, __HIP_MEMORY_SCOPE_WORKGROUP); }
        u32x4 pw0, pw1, pw2, pw3;
        pw0 = (u32x4){cvtpk(p0[0], p0[1]), cvtpk(p0[2], p0[3]), cvtpk(p0[4], p0[5]), cvtpk(p0[6], p0[7])};
        pw1 = (u32x4){cvtpk(p0[8], p0[9]), cvtpk(p0[10], p0[11]), cvtpk(p0[12], p0[13]), cvtpk(p0[14], p0[15])};
        pw2 = (u32x4){cvtpk(p1[0], p1[1]), cvtpk(p1[2], p1[3]), cvtpk(p1[4], p1[5]), cvtpk(p1[6], p1[7])};
        pw3 = (u32x4){cvtpk(p1[8], p1[9]), cvtpk(p1[10], p1[11]), cvtpk(p1[12], p1[13]), cvtpk(p1[14], p1[15])};
        pv(o, vp0 + kt * SLOTB, __builtin_bit_cast(bf16x8, pw0), __builtin_bit_cast(bf16x8, pw1), __builtin_bit_cast(bf16x8, pw2), __builtin_bit_cast(bf16x8, pw3));
    }
#undef CMP_SCORES
    if (hi == 0) wsf[r32] = invl;
    LDS_WAIT(); asm volatile("" ::: "memory");
#pragma unroll
    for (int r = 0; r < 16; ++r) { const float li = wsf[crow(r, hi)]; o[0][r] *= li; o[1][r] *= li; }
    LDS_WAIT(); asm volatile("" ::: "memory");
    __syncthreads();
    {   const int j = lane, cur = qb;
        const bool forced = (j == 0) || (j == cur) || (j == cur - 1), valid = j <= cur;
#pragma unroll 1
        for (int u = 0; u < 8; u += 4) {
            unsigned key[4], T[4];
#pragma unroll
            for (int v = 0; v < 4; ++v) { const LAS unsigned* ip = imp + (8 * wid + u + v) * IMPP + 4 * j;
                const unsigned sc0 = (j > 0 ? ip[-1] : 0u) + 2u * ip[0] + 2u * ip[1] + 2u * ip[2] + ip[3];
                key[v] = valid ? (forced ? 0xffffffffu : sc0 + 1u) : 0u; T[v] = 0u; }
#define BIS_STEP(BM) do { unsigned c0, c1, c2, c3, n0, n1, n2, n3; unsigned long long m0, m1, m2, m3; \
                asm volatile("s_or_b32 %[c0], %[t0], %[bm]\n\ts_or_b32 %[c1], %[t1], %[bm]\n\ts_or_b32 %[c2], %[t2], %[bm]\n\ts_or_b32 %[c3], %[t3], %[bm]\n\t" \
                             "v_cmp_le_u32_e64 %[m0], %[c0], %[k0]\n\tv_cmp_le_u32_e64 %[m1], %[c1], %[k1]\n\tv_cmp_le_u32_e64 %[m2], %[c2], %[k2]\n\tv_cmp_le_u32_e64 %[m3], %[c3], %[k3]\n\t" \
                             "s_bcnt1_i32_b64 %[n0], %[m0]\n\ts_bcnt1_i32_b64 %[n1], %[m1]\n\ts_bcnt1_i32_b64 %[n2], %[m2]\n\ts_bcnt1_i32_b64 %[n3], %[m3]\n\t" \
                             "s_cmp_ge_u32 %[n0], 16\n\ts_cselect_b32 %[t0], %[c0], %[t0]\n\ts_cmp_ge_u32 %[n1], 16\n\ts_cselect_b32 %[t1], %[c1], %[t1]\n\t" \
                             "s_cmp_ge_u32 %[n2], 16\n\ts_cselect_b32 %[t2], %[c2], %[t2]\n\ts_cmp_ge_u32 %[n3], 16\n\ts_cselect_b32 %[t3], %[c3], %[t3]" \
                             : [t0] "+s"(T[0]), [t1] "+s"(T[1]), [t2] "+s"(T[2]), [t3] "+s"(T[3]), [c0] "=&s"(c0), [c1] "=&s"(c1), [c2] "=&s"(c2), [c3] "=&s"(c3), \
                               [m0] "=&s"(m0), [m1] "=&s"(m1), [m2] "=&s"(m2), [m3] "=&s"(m3), [n0] "=&s"(n0), [n1] "=&s"(n1), [n2] "=&s"(n2), [n3] "=&s"(n3) \
                             : [k0] "v"(key[0]), [k1] "v"(key[1]), [k2] "v"(key[2]), [k3] "v"(key[3]), [bm] "n"(BM) : "scc"); } while (0)
#define BIS_4(B3) do { BIS_STEP(1u << (B3)); BIS_STEP(1u << ((B3) - 1)); BIS_STEP(1u << ((B3) - 2)); BIS_STEP(1u << ((B3) - 3)); } while (0)
#define BIS_FIN() (__builtin_popcountll(__ballot(key[0] >= T[0])) == 16 && __builtin_popcountll(__ballot(key[1] >= T[1])) == 16 && __builtin_popcountll(__ballot(key[2] >= T[2])) == 16 && __builtin_popcountll(__ballot(key[3] >= T[3])) == 16)
            do { BIS_4(31); if (BIS_FIN()) break; BIS_4(27); if (BIS_FIN()) break; BIS_4(23); if (BIS_FIN()) break; BIS_4(19); if (BIS_FIN()) break;
                 BIS_4(15); if (BIS_FIN()) break; BIS_4(11); if (BIS_FIN()) break; BIS_4(7); if (BIS_FIN()) break; BIS_4(3); } while (0);
#undef BIS_FIN
#undef BIS_4
#undef BIS_STEP
#pragma unroll
            for (int v = 0; v < 4; ++v) {
                const unsigned long long gtm = __ballot(key[v] > T[v]), eqm = __ballot(key[v] == T[v]);
                const int need = 16 - (int)__builtin_popcountll(gtm);
                const int eqrank = (int)__builtin_amdgcn_mbcnt_hi((unsigned)(eqm >> 32), __builtin_amdgcn_mbcnt_lo((unsigned)eqm, 0u));
                const unsigned long long msk = __ballot(valid && (key[v] > T[v] || (key[v] == T[v] && eqrank < need)));
                if (lane == 0) ((LAS unsigned long long*)(shm + L_SEL))[8 * wid + u + v] = msk; } }
    }
    LDS_WAIT(); asm volatile("" ::: "memory");
    __syncthreads();
}
}

__device__ __forceinline__ void phase_attn(const Args& a, LAS unsigned char* lds, int bid, int nb) {
    using namespace att;
    const int tid = threadIdx.x, lane = tid & 63, wid = __builtin_amdgcn_readfirstlane(tid >> 6);
    const int r32 = lane & 31, hi = lane >> 5, th = wid & 1, hr = wid >> 1;
    const bf16_t* Q = (const bf16_t*)(a.ws + WS_Q); const bf16_t* VSN = (const bf16_t*)(a.ws + WS_VSN); const bf16_t* VWN = (const bf16_t*)(a.ws + WS_VWN);
    const bf16_t* KSN = (const bf16_t*)(a.ws + WS_KSN); const bf16_t* KWN = (const bf16_t*)(a.ws + WS_KWN);
    const bf16_t* KCB = (const bf16_t*)(a.ws + WS_KCB); const bf16_t* VCB = (const bf16_t*)(a.ws + WS_VCB); bf16_t* OA = (bf16_t*)(a.ws + WS_OA);
    const float* GT = (const float*)(a.ws + WS_GT);
    const float* relb = a.in[I_RELB];
    LAS unsigned char* shm = lds;
    int gtab = -1;
    for (int it = bid; it < 1024; it += nb) {
        const int c = it & 255, k = it >> 8, x = c >> 4, bg = c & 15;
        const int qb = (k == 0) ? 63 - x : (k == 1) ? 32 + x : (k == 2) ? 31 - x : x;
        const int b = bg >> 1, g = bg & 1, h = g * 4 + hr;
        if (g != gtab) for (int e = tid; e < 1024; e += 512) { const int hh = e >> 8, d = 191 - (e & 255); ((LAS float*)(shm + L_BT))[e] = d < 0 ? -INFINITY : relb[t5_bucket(d) * 8 + g * 4 + hh] * LOG2E; }
        const float bfar = relb[31 * 8 + h] * LOG2E;
        __syncthreads();
        for (int e = tid; e < 768; e += 512) { const int tk = e / 12, c12 = e % 12; ((LAS float*)(shm + C_GT))[e] = GT[((size_t)b * SEQ + 64 * qb + tk) * 24 + g * 12 + c12]; }
        if (g != gtab) { const int hh = tid >> 7, e = tid & 127, d = e - 1; ((LAS float*)(shm + C_BT))[tid] = d < 0 ? -INFINITY : (relb[t5_bucket(min(d, 113)) * 8 + g * 4 + hh] - relb[31 * 8 + g * 4 + hh]) * LOG2E; }
        gtab = g;
        const int t = 64 * qb + 32 * th + r32; const size_t m = (size_t)b * SEQ + t;
        bf16x8 qr[4];
#pragma unroll
        for (int d0 = 0; d0 < 4; ++d0) qr[d0] = *(const bf16x8*)(Q + m * 512 + h * 64 + hi * 8 + d0 * 16);
        __syncthreads();
        f32x16 acc[2];
#define GATE_ACC(O, K, FIRST) do { const LAS float* gp_ = (const LAS float*)(shm + C_GT) + (32 * th + 4 * hi) * 12 + hr * 3 + (K); \
            _Pragma("unroll") for (int r = 0; r < 16; ++r) { const float gk = gp_[((r & 3) + 8 * (r >> 2)) * 12]; \
            if (FIRST) { acc[0][r] = gk * O[0][r]; acc[1][r] = gk * O[1][r]; } else { acc[0][r] += gk * O[0][r]; acc[1][r] += gk * O[1][r]; } } } while (0)
        LAS float* park = (LAS float*)(shm + C_IMP) + wid * 2048 + lane;
        { f32x16 oc[2]; cmp_branch(oc, shm, qr, KCB + (size_t)bg * 256 * 64, VCB + (size_t)bg * 256 * 64, qb, bfar, wid, lane); GATE_ACC(oc, 0, true);
#pragma unroll
          for (int r = 0; r < 16; ++r) { park[r * 64] = acc[0][r]; park[(16 + r) * 64] = acc[1][r]; } }
        const unsigned long long sel = ((const LAS unsigned long long*)(shm + L_SEL))[32 * th + r32];
        { f32x16 os[2]; branch<0>(os, shm, qr, KSN + (size_t)b * SEQ * 128 + g * 64, VSN + (size_t)b * SEQ * 128 + g * 64, qb, sel, bfar, wid, lane);
#pragma unroll
          for (int r = 0; r < 16; ++r) { acc[0][r] = park[r * 64]; acc[1][r] = park[(16 + r) * 64]; }
          GATE_ACC(os, 1, false);
#pragma unroll
          for (int r = 0; r < 16; ++r) { park[r * 64] = acc[0][r]; park[(16 + r) * 64] = acc[1][r]; } }
        { f32x16 ow[2]; branch<1>(ow, shm, qr, KWN + (size_t)b * SEQ * 128 + g * 64, VWN + (size_t)b * SEQ * 128 + g * 64, qb, sel, bfar, wid, lane);
#pragma unroll
          for (int r = 0; r < 16; ++r) { acc[0][r] = park[r * 64]; acc[1][r] = park[(16 + r) * 64]; }
          GATE_ACC(ow, 2, false); }
#undef GATE_ACC
#pragma unroll
        for (int r = 0; r < 16; ++r) { const size_t mm = (size_t)b * SEQ + 64 * qb + 32 * th + crow(r, hi);
#pragma unroll
            for (int d0 = 0; d0 < 2; ++d0) OA[mm * 512 + h * 64 + 32 * d0 + r32] = (bf16_t)(cvtpk(acc[d0][r], 0.f) & 0xffffu); }
    }
}
namespace rk {
constexpr int PITCH = 144;
constexpr int SLOT = 64 * PITCH;
constexpr size_t RS_MP = 40 * MiB, RS_NN = 72 * MiB, RS_Y0 = 136 * MiB, RS_GCB = 168 * MiB;
__device__ __forceinline__ size_t rs_rh_off(int it) {
    return it < 1792 ? 170 * MiB + (size_t)it * 8192 : it < 3136 ? 1 * MiB + (size_t)(it - 1792) * 8192 : it < 3520 ? 35 * MiB + (size_t)(it - 3136) * 8192
         : it < 3776 ? 33 * MiB + (size_t)(it - 3520) * 8192 : 508 * MiB + (size_t)(it - 3776) * 8192;
}
constexpr size_t WS_W2T = 38 * MiB, WS_A2T = WS_W2T + 65536, WS_G2T = WS_A2T + 65536;
__device__ __forceinline__ int crow(int r, int hi) { return (r & 3) + 8 * (r >> 2) + 4 * hi; }
__device__ __forceinline__ unsigned cvtpk(float lo, float hi) { typedef float f2_ __attribute__((ext_vector_type(2))); typedef __bf16 b2_ __attribute__((ext_vector_type(2))); const f2_ v = {lo, hi}; const b2_ b = __builtin_convertvector(v, b2_); return __builtin_bit_cast(unsigned, b); }
__device__ __forceinline__ float fexp(float x) { return __builtin_amdgcn_exp2f(x * 1.4426950408889634f); }
__device__ __forceinline__ float ftanh(float x) { const float e = __builtin_amdgcn_exp2f(x * 2.8853900817779268f); return 1.0f - 2.0f * __builtin_amdgcn_rcpf(e + 1.0f); }
__device__ __forceinline__ float fsoftplus(float x) { return x > 20.f ? x : 0.6931471805599453f * __builtin_amdgcn_logf(1.0f + __builtin_amdgcn_exp2f(x * 1.4426950408889634f)); }
__device__ __forceinline__ float fsigm(float x) { return __builtin_amdgcn_rcpf(1.0f + __builtin_amdgcn_exp2f(-x * 1.4426950408889634f)); }
__device__ __forceinline__ unsigned cvt1(float x) { return cvtpk(x, 0.f) & 0xffffu; }
__device__ __forceinline__ f32x16 zero16() { return (f32x16){0.f, 0.f, 0.f, 0.f, 0.f, 0.f, 0.f, 0.f, 0.f, 0.f, 0.f, 0.f, 0.f, 0.f, 0.f, 0.f}; }
__device__ __forceinline__ void tile_nt(f32x16& acc, const LAS unsigned char* XA, int ta, const LAS unsigned char* YB, int tb, int r32, int hi) {
    const LAS unsigned char* pa = XA + (32 * ta + r32) * PITCH + 16 * hi; const LAS unsigned char* pb = YB + (32 * tb + r32) * PITCH + 16 * hi;
    bf16x8 fa[4], fb[4];
#pragma unroll
    for (int ks = 0; ks < 4; ++ks) { fa[ks] = *(const LAS bf16x8*)(pa + 32 * ks); fb[ks] = *(const LAS bf16x8*)(pb + 32 * ks); }
    __builtin_amdgcn_sched_barrier(0);
#pragma unroll
    for (int ks = 0; ks < 4; ++ks) acc = __builtin_amdgcn_mfma_f32_32x32x16_bf16(fa[ks], fb[ks], acc, 0, 0, 0);
}
__device__ __forceinline__ void tile_nt2(f32x16& acc, f32x16& acc2, const LAS unsigned char* XA, int ta, const LAS unsigned char* YB, const LAS unsigned char* YB2, int tb, int r32, int hi) {
    const LAS unsigned char* pa = XA + (32 * ta + r32) * PITCH + 16 * hi; const LAS unsigned char* pb = YB + (32 * tb + r32) * PITCH + 16 * hi; const LAS unsigned char* pc = YB2 + (32 * tb + r32) * PITCH + 16 * hi;
#pragma unroll
    for (int h2 = 0; h2 < 2; ++h2) {
        const bf16x8 a0 = *(const LAS bf16x8*)(pa + 64 * h2), a1 = *(const LAS bf16x8*)(pa + 64 * h2 + 32), b0 = *(const LAS bf16x8*)(pb + 64 * h2), b1 = *(const LAS bf16x8*)(pb + 64 * h2 + 32),
                     c0 = *(const LAS bf16x8*)(pc + 64 * h2), c1 = *(const LAS bf16x8*)(pc + 64 * h2 + 32);
        __builtin_amdgcn_sched_barrier(0);
        acc = __builtin_amdgcn_mfma_f32_32x32x16_bf16(a0, b0, acc, 0, 0, 0); acc2 = __builtin_amdgcn_mfma_f32_32x32x16_bf16(a0, c0, acc2, 0, 0, 0);
        acc = __builtin_amdgcn_mfma_f32_32x32x16_bf16(a1, b1, acc, 0, 0, 0); acc2 = __builtin_amdgcn_mfma_f32_32x32x16_bf16(a1, c1, acc2, 0, 0, 0);
    }
}
__device__ __forceinline__ void wr_t(LAS unsigned char* D, const f32x16& acc, int ta, int tb, int r32, int hi) {
#pragma unroll
    for (int q = 0; q < 4; ++q) { u32x2 w; w.x = cvtpk(acc[4 * q], acc[4 * q + 1]); w.y = cvtpk(acc[4 * q + 2], acc[4 * q + 3]);
        *(LAS u32x2*)(D + (32 * tb + r32) * PITCH + (32 * ta + 8 * q + 4 * hi) * 2) = w; }
}
__device__ __forceinline__ void wr_d(LAS unsigned char* D, const f32x16& acc, int ta, int tb, int r32, int hi) {
#pragma unroll
    for (int r = 0; r < 16; r += 2) { const unsigned w = cvtpk(acc[r], acc[r + 1]);
        *(LAS bf16_t*)(D + (32 * ta + crow(r, hi)) * PITCH + (32 * tb + r32) * 2) = (bf16_t)(w & 0xffffu); *(LAS bf16_t*)(D + (32 * ta + crow(r + 1, hi)) * PITCH + (32 * tb + r32) * 2) = (bf16_t)(w >> 16); }
}
}

__device__ __forceinline__ void rwkv_pass1(const Args& a, LAS unsigned char* lds, int bid, int nb) {
    using namespace rk;
    const int tid = threadIdx.x, lane = tid & 63, wid = __builtin_amdgcn_readfirstlane(tid >> 6), r32 = lane & 31, hi = lane >> 5;
    const bf16_t* RW = (const bf16_t*)(a.ws + WS_RW); const float* mu = a.in[I_MU];
    const bf16_t* W2T = (const bf16_t*)(a.ws + WS_W2T); const bf16_t* A2T = (const bf16_t*)(a.ws + WS_A2T);
#define SL(k) (lds + (k) * SLOT)
    LAS float* WP = (LAS float*)(lds + 8 * SLOT);
    LAS float* AP = (LAS float*)(lds + 8 * SLOT + 17408);
    LAS float* CL = (LAS float*)(lds + 8 * SLOT + 2 * 17408);
    LAS float* SEG = CL + 64 * 68; LAS float* CLAST = SEG + 8 * 68;
    const int tj = tid >> 3, jb = (tid & 7) * 8;
    const int tile = wid & 3, ta = tile >> 1, tb = tile & 1, grp = wid >> 2;
#define LBAR() do { asm volatile("s_waitcnt lgkmcnt(0)" ::: "memory"); __builtin_amdgcn_s_barrier(); asm volatile("" ::: "memory"); } while (0)
    u32x4 fa0, fa1, fb0, fb1, fr0, fr1, fk0, fk1, fv0, fv1;
#define LOAD_RAW(itx) do { const int c_ = (itx) & 63, h_ = ((itx) >> 6) & 7, b_ = (itx) >> 9; const size_t mr_ = (size_t)b_ * SEQ + 64 * c_ + (tid >> 3); const bool hp_ = (64 * c_ + (tid >> 3)) > 0; \
        const bf16_t* r1_ = RW + mr_ * 1792 + 1536 + (tid & 7) * 16; const bf16_t* r3_ = RW + mr_ * 1792 + h_ * 64 + (tid & 7) * 8; const u32x4 z_ = (u32x4){0u, 0u, 0u, 0u}; \
        fa0 = *(const u32x4*)r1_; fa1 = *(const u32x4*)(r1_ + 8); fb0 = hp_ ? *(const u32x4*)(r1_ - 1792) : z_; fb1 = hp_ ? *(const u32x4*)(r1_ - 1792 + 8) : z_; \
        fr0 = *(const u32x4*)r3_; fk0 = *(const u32x4*)(r3_ + 512); fv0 = *(const u32x4*)(r3_ + 1024); \
        fr1 = hp_ ? *(const u32x4*)(r3_ - 1792) : z_; fk1 = hp_ ? *(const u32x4*)(r3_ - 1792 + 512) : z_; fv1 = hp_ ? *(const u32x4*)(r3_ - 1792 + 1024) : z_; } while (0)
    const f32x4 m0_ = *(const f32x4*)(mu + 1536 + (tid & 7) * 16), m1_ = *(const f32x4*)(mu + 1536 + (tid & 7) * 16 + 4), m2_ = *(const f32x4*)(mu + 1536 + (tid & 7) * 16 + 8), m3_ = *(const f32x4*)(mu + 1536 + (tid & 7) * 16 + 12);
    if (bid < 4096) LOAD_RAW(bid);
    for (int it = bid; it < 4096; it += nb) {
        const int c = it & 63, h = (it >> 6) & 7, b = it >> 9; const int t0 = 64 * c; const size_t m0 = (size_t)b * SEQ + t0;
        {   const int t = tid >> 3, c0 = (tid & 7) * 16; const int col = 1536 + c0; const size_t m = m0 + t;
            const u32x4 p0 = fa0, p1 = fa1, s0 = fb0, s1 = fb1; (void)m;
            float x[16]; const unsigned pw[8] = {p0.x, p0.y, p0.z, p0.w, p1.x, p1.y, p1.z, p1.w}, sw[8] = {s0.x, s0.y, s0.z, s0.w, s1.x, s1.y, s1.z, s1.w};
            const float mv[16] = {m0_.x, m0_.y, m0_.z, m0_.w, m1_.x, m1_.y, m1_.z, m1_.w, m2_.x, m2_.y, m2_.z, m2_.w, m3_.x, m3_.y, m3_.z, m3_.w};
#pragma unroll
            for (int e = 0; e < 8; ++e) { const float pl_ = bflo(pw[e]), ph_ = bfhi(pw[e]); x[2 * e] = pl_ + (bflo(sw[e]) - pl_) * mv[2 * e]; x[2 * e + 1] = ph_ + (bfhi(sw[e]) - ph_) * mv[2 * e + 1]; }
            if (c0 < 64) {
#pragma unroll
                for (int e = 0; e < 16; ++e) x[e] = ftanh(x[e]); }
            LAS unsigned char* dst = (c0 < 64 ? SL(14) : SL(15)) + t * PITCH + (c0 & 63) * 2;
            *(LAS u32x4*)dst = (u32x4){cvtpk(x[0], x[1]), cvtpk(x[2], x[3]), cvtpk(x[4], x[5]), cvtpk(x[6], x[7])};
            *(LAS u32x4*)(dst + 16) = (u32x4){cvtpk(x[8], x[9]), cvtpk(x[10], x[11]), cvtpk(x[12], x[13]), cvtpk(x[14], x[15])};
        }
        bf16x8 wf[4];
        {   const bf16_t* WT = (grp == 0 ? W2T : A2T) + (size_t)(h * 64 + 32 * ta + r32) * 64 + 8 * hi;
#pragma unroll
            for (int ks = 0; ks < 4; ++ks) wf[ks] = *(const bf16x8*)(WT + 16 * ks); }
        LBAR();
        {   const LAS unsigned char* pb = (grp == 0 ? SL(14) : SL(15)) + (32 * tb + r32) * PITCH + 16 * hi;
            f32x16 acc = zero16(); bf16x8 xf_[4];
#pragma unroll
            for (int ks = 0; ks < 4; ++ks) xf_[ks] = *(const LAS bf16x8*)(pb + 32 * ks);
            __builtin_amdgcn_sched_barrier(0);
#pragma unroll
            for (int ks = 0; ks < 4; ++ks) acc = __builtin_amdgcn_mfma_f32_32x32x16_bf16(wf[ks], xf_[ks], acc, 0, 0, 0);
            LAS float* D = grp == 0 ? WP : AP;
#pragma unroll
            for (int q = 0; q < 4; ++q) *(LAS f32x4*)(D + (32 * tb + r32) * 68 + 32 * ta + 8 * q + 4 * hi) = (f32x4){acc[4 * q], acc[4 * q + 1], acc[4 * q + 2], acc[4 * q + 3]};
        }
        f32x4 pq[16];
        {   const int hj = h * 64 + jb;
#pragma unroll
            for (int q = 0; q < 3; ++q) { pq[2 * q] = *(const f32x4*)(mu + q * 512 + hj); pq[2 * q + 1] = *(const f32x4*)(mu + q * 512 + hj + 4); }
            pq[6] = *(const f32x4*)(a.in[I_W0] + hj); pq[7] = *(const f32x4*)(a.in[I_W0] + hj + 4); pq[8] = *(const f32x4*)(a.in[I_A0] + hj); pq[9] = *(const f32x4*)(a.in[I_A0] + hj + 4);
            pq[10] = *(const f32x4*)(a.in[I_KK] + hj); pq[11] = *(const f32x4*)(a.in[I_KK] + hj + 4); pq[12] = *(const f32x4*)(a.in[I_KA] + hj); pq[13] = *(const f32x4*)(a.in[I_KA] + hj + 4);
            pq[14] = *(const f32x4*)(a.in[I_RK] + hj); pq[15] = *(const f32x4*)(a.in[I_RK] + hj + 4); }
        LBAR();
        float rr[8], kp[8], av[8], bv[8], lw[8];
        {   const size_t m = m0 + tj; const int hj = h * 64 + jb; const bool hasp = (t0 + tj) > 0;
            float x3[3][8];
#pragma unroll
            for (int q = 0; q < 3; ++q) { const int col = q * 512 + hj; const u32x4 p = q == 0 ? fr0 : q == 1 ? fk0 : fv0; const u32x4 s = q == 0 ? fr1 : q == 1 ? fk1 : fv1; (void)m; (void)hasp;
                const unsigned pw[4] = {p.x, p.y, p.z, p.w}, sw[4] = {s.x, s.y, s.z, s.w}; const f32x4 ma_ = pq[2 * q], mb_ = pq[2 * q + 1]; (void)col; const float mv[8] = {ma_.x, ma_.y, ma_.z, ma_.w, mb_.x, mb_.y, mb_.z, mb_.w};
#pragma unroll
                for (int e = 0; e < 4; ++e) { const float pl_ = bflo(pw[e]), ph_ = bfhi(pw[e]); x3[q][2 * e] = pl_ + (bflo(sw[e]) - pl_) * mv[2 * e]; x3[q][2 * e + 1] = ph_ + (bfhi(sw[e]) - ph_) * mv[2 * e + 1]; } }
            const f32x4 wp0 = *(const LAS f32x4*)(WP + tj * 68 + jb), wp1 = *(const LAS f32x4*)(WP + tj * 68 + jb + 4), ap0 = *(const LAS f32x4*)(AP + tj * 68 + jb), ap1 = *(const LAS f32x4*)(AP + tj * 68 + jb + 4);
            const float wpre[8] = {wp0.x, wp0.y, wp0.z, wp0.w, wp1.x, wp1.y, wp1.z, wp1.w}, apre[8] = {ap0.x, ap0.y, ap0.z, ap0.w, ap1.x, ap1.y, ap1.z, ap1.w};
            float ssq = 0.f, bon = 0.f, kkr[8];
#define LD8(arr, name) const f32x4 name##a_ = pq[arr], name##b_ = pq[arr + 1]; const float name[8] = {name##a_.x, name##a_.y, name##a_.z, name##a_.w, name##b_.x, name##b_.y, name##b_.z, name##b_.w}
            LD8(6, pw0); LD8(8, pa0); LD8(10, pkk); LD8(12, pka); LD8(14, prk);
#undef LD8
#pragma unroll
            for (int e = 0; e < 8; ++e) {
                lw[e] = -0.6065306597126334f * fsigm(pw0[e] + wpre[e]);
                const float aa = fsigm(pa0[e] + apre[e]);
                const float r = x3[0][e], k = x3[1][e]; *(LAS bf16_t*)(SL(7) + (jb + e) * PITCH + tj * 2) = (bf16_t)cvt1(x3[2][e]); rr[e] = r;
                kkr[e] = k * pkk[e]; ssq += kkr[e] * kkr[e];
                kp[e] = k * (1.0f + (aa - 1.0f) * pka[e]); bon += r * kp[e] * prk[e]; av[e] = aa;
            }
            ssq += __shfl_xor(ssq, 1); ssq += __shfl_xor(ssq, 2); ssq += __shfl_xor(ssq, 4);
            bon += __shfl_xor(bon, 1); bon += __shfl_xor(bon, 2); bon += __shfl_xor(bon, 4);
            const float inv = 1.0f / fmaxf(sqrtf(ssq), 1e-12f);
#pragma unroll
            for (int e = 0; e < 8; ++e) { const float kk = kkr[e] * inv; bv[e] = kk * av[e]; av[e] = -kk; }
            if ((tid & 7) == 0) ((float*)(a.ws + RS_GCB))[(size_t)it * 128 + 64 + tj] = bon;
            *(LAS f32x4*)(WP + tj * 68 + jb) = (f32x4){lw[0], lw[1], lw[2], lw[3]}; *(LAS f32x4*)(WP + tj * 68 + jb + 4) = (f32x4){lw[4], lw[5], lw[6], lw[7]};
        }
        LBAR();
        {   const int j = tid & 63, sg = tid >> 6; float run = 0.f;
#pragma unroll
            for (int u = 0; u < 8; ++u) { run += WP[(8 * sg + u) * 68 + j]; CL[(8 * sg + u) * 68 + j] = run; }
            SEG[sg * 68 + j] = run;
        }
        LBAR();
        {   const int j = tid & 63, sg = tid >> 6; float off = 0.f;
            for (int s = 0; s < sg; ++s) off += SEG[s * 68 + j];
#pragma unroll
            for (int u = 0; u < 8; ++u) CL[(8 * sg + u) * 68 + j] += off;
            if (sg == 7) CLAST[j] = off + SEG[7 * 68 + j];
        }
        LBAR();
        {   const f32x4 c0 = *(const LAS f32x4*)(CL + tj * 68 + jb), c1 = *(const LAS f32x4*)(CL + tj * 68 + jb + 4), e0 = *(const LAS f32x4*)(CLAST + jb), e1 = *(const LAS f32x4*)(CLAST + jb + 4);
            const float cl[8] = {c0.x, c0.y, c0.z, c0.w, c1.x, c1.y, c1.z, c1.w}, ce[8] = {e0.x, e0.y, e0.z, e0.w, e1.x, e1.y, e1.z, e1.w};
            float At[8], Rt[8], Bt[8], Kt[8], Bc[8], Kc[8];
#pragma unroll
            for (int e = 0; e < 8; ++e) { const float c2 = cl[e] * 1.4426950408889634f, e2 = ce[e] * 1.4426950408889634f, l2 = lw[e] * 1.4426950408889634f;
                const float G = __builtin_amdgcn_exp2f(c2), Gm1 = __builtin_amdgcn_exp2f(c2 - l2), iG = __builtin_amdgcn_exp2f(-c2), Gr = __builtin_amdgcn_exp2f(e2 - c2);
                At[e] = av[e] * Gm1; Rt[e] = rr[e] * G; Bt[e] = bv[e] * iG; Kt[e] = kp[e] * iG; Bc[e] = bv[e] * Gr; Kc[e] = kp[e] * Gr; }
#define PK8(v) (u32x4){cvtpk(v[0], v[1]), cvtpk(v[2], v[3]), cvtpk(v[4], v[5]), cvtpk(v[6], v[7])}
            *(LAS u32x4*)(SL(0) + tj * PITCH + jb * 2) = PK8(At); *(LAS u32x4*)(SL(4) + tj * PITCH + jb * 2) = PK8(Rt);
            *(LAS u32x4*)(SL(1) + tj * PITCH + jb * 2) = PK8(Bt); *(LAS u32x4*)(SL(2) + tj * PITCH + jb * 2) = PK8(Kt);
#undef PK8
#pragma unroll
            for (int e = 0; e < 8; e += 2) { const unsigned wa = cvtpk(At[e], At[e + 1]), wb = cvtpk(Bc[e], Bc[e + 1]), wk = cvtpk(Kc[e], Kc[e + 1]);
                *(LAS bf16_t*)(SL(3) + (jb + e) * PITCH + tj * 2) = (bf16_t)(wa & 0xffffu); *(LAS bf16_t*)(SL(3) + (jb + e + 1) * PITCH + tj * 2) = (bf16_t)(wa >> 16);
                *(LAS bf16_t*)(SL(5) + (jb + e) * PITCH + tj * 2) = (bf16_t)(wb & 0xffffu); *(LAS bf16_t*)(SL(5) + (jb + e + 1) * PITCH + tj * 2) = (bf16_t)(wb >> 16);
                *(LAS bf16_t*)(SL(6) + (jb + e) * PITCH + tj * 2) = (bf16_t)(wk & 0xffffu); *(LAS bf16_t*)(SL(6) + (jb + e + 1) * PITCH + tj * 2) = (bf16_t)(wk >> 16); }
            if (tj == 0) { float* gc = (float*)(a.ws + RS_GCB) + (size_t)it * 128 + jb;
#pragma unroll
                for (int e = 0; e < 8; ++e) gc[e] = fexp(ce[e]); }
        }
        LBAR();
        if (it + nb < 4096) LOAD_RAW(it + nb);
        {   f32x16 acc = zero16(), acc2 = zero16();
            tile_nt2(acc, acc2, grp == 0 ? SL(1) : SL(2), ta, SL(0), SL(4), tb, r32, hi);
            const int tt = 32 * tb + r32;
#pragma unroll
            for (int r = 0; r < 16; ++r) { const int s = 32 * ta + crow(r, hi); acc[r] = s < tt ? acc[r] : 0.f; acc2[r] = s <= tt ? acc2[r] : 0.f; }
            if (grp == 0) { wr_t(SL(8), acc, ta, tb, r32, hi); wr_d(SL(9), acc, ta, tb, r32, hi);
#pragma unroll
                for (int r = 0; r < 16; ++r) acc[r] += (32 * ta + crow(r, hi) == tt) ? 1.0f : 0.f;
                wr_t(SL(13), acc, ta, tb, r32, hi); wr_t(SL(11), acc2, ta, tb, r32, hi); }
            else { wr_t(SL(10), acc, ta, tb, r32, hi); wr_t(SL(12), acc2, ta, tb, r32, hi); }
        }
        LBAR();
        {   f32x16 acc = zero16();
            if (grp == 0) { tile_nt(acc, SL(9), ta, SL(8), tb, r32, hi); wr_t(SL(0), acc, ta, tb, r32, hi); wr_d(SL(1), acc, ta, tb, r32, hi); }
            else { tile_nt(acc, SL(10), ta, SL(7), tb, r32, hi); wr_t(SL(14), acc, ta, tb, r32, hi); }
        }
        LBAR();
#pragma unroll
        for (int k = 1; k <= 3; ++k) {
            const int qr = (k & 1) ? 0 : 8, qt = qr + 1, qr2 = (k & 1) ? 8 : 0, qt2 = qr2 + 1, tr_ = (k & 1) ? 13 : 2, tr2 = (k & 1) ? 2 : 13;
            f32x16 acc = zero16();
            if (grp == 0) { if (k < 3) { tile_nt(acc, SL(qt), ta, SL(qr), tb, r32, hi); wr_t(SL(qr2), acc, ta, tb, r32, hi); wr_d(SL(qt2), acc, ta, tb, r32, hi); } }
            else { tile_nt(acc, SL(qt), ta, SL(tr_), tb, r32, hi);
#pragma unroll
                for (int q = 0; q < 4; ++q) { const u32x2 o = *(const LAS u32x2*)(SL(tr_) + (32 * tb + r32) * PITCH + (32 * ta + 8 * q + 4 * hi) * 2);
                    acc[4 * q] += bflo(o.x); acc[4 * q + 1] += bfhi(o.x); acc[4 * q + 2] += bflo(o.y); acc[4 * q + 3] += bfhi(o.y); }
                wr_t(SL(tr2), acc, ta, tb, r32, hi); }
            LBAR();
        }
        {   f32x16 acc = zero16();
            if (grp == 0) { tile_nt(acc, SL(2), ta, SL(3), tb, r32, hi); wr_t(SL(10), acc, ta, tb, r32, hi); }
            else { tile_nt(acc, SL(2), ta, SL(14), tb, r32, hi); wr_t(SL(15), acc, ta, tb, r32, hi); }
        }
        LBAR();
        {   unsigned char* ws = a.ws;
            if (grp == 0) {
                f32x16 acc = zero16(); tile_nt(acc, SL(10), ta, SL(11), tb, r32, hi);
                bf16_t* RH = (bf16_t*)(ws + rs_rh_off(it));
#pragma unroll
                for (int q = 0; q < 4; ++q) { const int t = 32 * tb + r32, j = 32 * ta + 8 * q + 4 * hi; const u32x2 o = *(const LAS u32x2*)(SL(4) + t * PITCH + j * 2);
                    u32x2 w; w.x = cvtpk(acc[4 * q] + bflo(o.x), acc[4 * q + 1] + bfhi(o.x)); w.y = cvtpk(acc[4 * q + 2] + bflo(o.y), acc[4 * q + 3] + bfhi(o.y)); *(u32x2*)(RH + t * 64 + j) = w; }
                f32x16 y = zero16(); tile_nt(y, SL(15), ta, SL(11), tb, r32, hi); tile_nt(y, SL(7), ta, SL(12), tb, r32, hi);
                bf16_t* Y0 = (bf16_t*)(ws + RS_Y0) + (size_t)it * 4096 + (tile * 64 + lane) * 16;
                *(u32x4*)Y0 = (u32x4){cvtpk(y[0], y[1]), cvtpk(y[2], y[3]), cvtpk(y[4], y[5]), cvtpk(y[6], y[7])}; *(u32x4*)(Y0 + 8) = (u32x4){cvtpk(y[8], y[9]), cvtpk(y[10], y[11]), cvtpk(y[12], y[13]), cvtpk(y[14], y[15])};
            } else {
                f32x16 acc = zero16(); tile_nt(acc, SL(10), ta, SL(5), tb, r32, hi);
                bf16_t* MP = (bf16_t*)(ws + RS_MP) + (size_t)it * 4096;
#pragma unroll
                for (int q = 0; q < 4; ++q) { const int j = 32 * tb + r32, j2 = 32 * ta + 8 * q + 4 * hi; u32x2 w; w.x = cvtpk(acc[4 * q], acc[4 * q + 1]); w.y = cvtpk(acc[4 * q + 2], acc[4 * q + 3]); *(u32x2*)(MP + j * 64 + j2) = w; }
                f32x16 n = zero16(); tile_nt(n, SL(5), ta, SL(15), tb, r32, hi); tile_nt(n, SL(6), ta, SL(7), tb, r32, hi);
                bf16_t* NN = (bf16_t*)(ws + RS_NN) + (size_t)it * 4096 + (tile * 64 + lane) * 16;
                *(u32x4*)NN = (u32x4){cvtpk(n[0], n[1]), cvtpk(n[2], n[3]), cvtpk(n[4], n[5]), cvtpk(n[6], n[7])}; *(u32x4*)(NN + 8) = (u32x4){cvtpk(n[8], n[9]), cvtpk(n[10], n[11]), cvtpk(n[12], n[13]), cvtpk(n[14], n[15])};
            }
        }
        LBAR();
    }
#undef SL
#undef LOAD_RAW
#undef LBAR
}

__device__ __forceinline__ void rwkv_pass2(const Args& a, LAS unsigned char* lds, int bid, int nb) {
    using namespace rk;
    const int tid = threadIdx.x, lane = tid & 63, wid = __builtin_amdgcn_readfirstlane(tid >> 6), r32 = lane & 31, hi = lane >> 5;
    const int ta = (wid & 3) >> 1, tb = wid & 1;
    for (int bh = bid; bh < 64; bh += nb) {
        __syncthreads();
        for (int e = tid; e < 2 * SLOT / 4; e += 512) ((LAS unsigned*)lds)[e] = 0u;
        __syncthreads();
        f32x16 st = zero16();
        if (wid < 4) {
            const bf16_t* MPb = (const bf16_t*)(a.ws + RS_MP) + (size_t)bh * 64 * 4096 + (32 * ta + r32) * 64 + 8 * hi;
            const float* gcb = (const float*)(a.ws + RS_GCB) + (size_t)bh * 64 * 128 + 32 * ta + 4 * hi;
            const bf16_t* NNb = (const bf16_t*)(a.ws + RS_NN) + (size_t)bh * 64 * 4096 + ((ta * 2 + tb) * 64 + lane) * 16;
            bf16x8 mfA[4], mfB[4], mfC[4]; f32x4 gA[4], gB[4], gC[4]; u32x4 nA0, nA1, nB0, nB1, nC0, nC1;
#define P2_LD(mf, g, n0, n1, cc) { const int c_ = (cc) < 62 ? (cc) : 62; \
                _Pragma("unroll") for (int ks = 0; ks < 4; ++ks) mf[ks] = *(const bf16x8*)(MPb + (size_t)c_ * 4096 + 16 * ks); \
                _Pragma("unroll") for (int q = 0; q < 4; ++q) g[q] = *(const f32x4*)(gcb + (size_t)c_ * 128 + 8 * q); \
                n0 = *(const u32x4*)(NNb + (size_t)c_ * 4096); n1 = *(const u32x4*)(NNb + (size_t)c_ * 4096 + 8); }
#define P2_STEP(mf, g, n0, n1, cc) { const int c_ = (cc); \
                const unsigned nw[8] = {n0.x, n0.y, n0.z, n0.w, n1.x, n1.y, n1.z, n1.w}; \
                _Pragma("unroll") for (int q = 0; q < 4; ++q) { \
                    st[4 * q] = st[4 * q] * g[q].x + bflo(nw[2 * q]); st[4 * q + 1] = st[4 * q + 1] * g[q].y + bfhi(nw[2 * q]); st[4 * q + 2] = st[4 * q + 2] * g[q].z + bflo(nw[2 * q + 1]); st[4 * q + 3] = st[4 * q + 3] * g[q].w + bfhi(nw[2 * q + 1]); } \
                const LAS unsigned char* pb = lds + (c_ & 1) * SLOT + (32 * tb + r32) * PITCH + 16 * hi;          \
                { const bf16x8 sf0_ = *(const LAS bf16x8*)(pb), sf1_ = *(const LAS bf16x8*)(pb + 32), sf2_ = *(const LAS bf16x8*)(pb + 64), sf3_ = *(const LAS bf16x8*)(pb + 96);     \
                  __builtin_amdgcn_sched_barrier(0); \
                  f32x16 s2_ = __builtin_amdgcn_mfma_f32_32x32x16_bf16(mf[2], sf2_, zero16(), 0, 0, 0);     \
                  st = __builtin_amdgcn_mfma_f32_32x32x16_bf16(mf[0], sf0_, st, 0, 0, 0); s2_ = __builtin_amdgcn_mfma_f32_32x32x16_bf16(mf[3], sf3_, s2_, 0, 0, 0); \
                  st = __builtin_amdgcn_mfma_f32_32x32x16_bf16(mf[1], sf1_, st, 0, 0, 0); _Pragma("unroll") for (int r_ = 0; r_ < 16; ++r_) st[r_] += s2_[r_]; } \
                  \
                LAS unsigned char* Sn = lds + ((c_ + 1) & 1) * SLOT; bf16_t* SG = (bf16_t*)(a.ws + RS_MP) + ((size_t)bh * 64 + c_) * 4096; \
                asm volatile("s_waitcnt lgkmcnt(0)" ::: "memory"); \
                __builtin_amdgcn_s_barrier(); asm volatile("" ::: "memory");    \
                _Pragma("unroll") for (int q = 0; q < 4; ++q) { u32x2 w; w.x = cvtpk(st[4 * q], st[4 * q + 1]); w.y = cvtpk(st[4 * q + 2], st[4 * q + 3]); \
                    const int i = 32 * tb + r32, j = 32 * ta + 8 * q + 4 * hi; \
                    *(LAS u32x2*)(Sn + i * PITCH + j * 2) = w; *(u32x2*)(SG + i * 64 + j) = w; } \
                asm volatile("s_waitcnt lgkmcnt(0)" ::: "memory"); \
                __builtin_amdgcn_s_barrier(); asm volatile("" ::: "memory"); }
            P2_LD(mfA, gA, nA0, nA1, 0) P2_LD(mfB, gB, nB0, nB1, 1)
#pragma unroll 1
            for (int c = 0; c < 63; c += 3) {
                P2_LD(mfC, gC, nC0, nC1, c + 2) P2_STEP(mfA, gA, nA0, nA1, c)
                P2_LD(mfA, gA, nA0, nA1, c + 3) P2_STEP(mfB, gB, nB0, nB1, c + 1)
                P2_LD(mfB, gB, nB0, nB1, c + 4) P2_STEP(mfC, gC, nC0, nC1, c + 2)
            }
#undef P2_LD
#undef P2_STEP
        } else {
            for (int c = 0; c < 63; ++c) { asm volatile("" ::: "memory"); __builtin_amdgcn_s_barrier(); asm volatile("" ::: "memory"); __builtin_amdgcn_s_barrier(); asm volatile("" ::: "memory"); }
        }
    }
}

__device__ __forceinline__ void rwkv_pass3(const Args& a, LAS unsigned char* lds, int bid, int nb) {
    using namespace rk;
    const int tid = threadIdx.x, lane = tid & 63, wid = tid >> 6, r32 = lane & 31, hi = lane >> 5;
    LAS unsigned char* vb = lds + wid * (72 * PITCH);
    const bf16_t* RW = (const bf16_t*)(a.ws + WS_RW); const float* mu = a.in[I_MU]; bf16_t* OB = (bf16_t*)(a.ws + WS_OB);
    const bf16_t* G2T = (const bf16_t*)(a.ws + WS_G2T);
    LAS unsigned char* g2l = lds + 98304; LAS float* mgl = (LAS float*)(lds + 115712);
    {   const bf16_t* gsrc = G2T + (size_t)((bid >> 3) & 7) * 64 * 128;
#pragma unroll
        for (int i = 0; i < 2; ++i) { const int e = tid + 512 * i, row = e >> 4, ch = e & 15; *(LAS u32x4*)(g2l + row * 272 + ch * 16) = *(const u32x4*)(gsrc + row * 128 + ch * 8); }
        if (tid < 128) mgl[tid] = mu[1664 + tid];
        {   LAS float* prm_ = (LAS float*)(lds + 90112); const int h0 = (bid >> 3) & 7;
            if (tid < 64) prm_[tid] = mu[1024 + h0 * 64 + tid]; else if (tid < 128) prm_[tid] = a.in[I_LNG][h0 * 64 + tid - 64]; else if (tid < 192) prm_[tid] = a.in[I_LNB][h0 * 64 + tid - 128]; }
        __syncthreads(); }
    const LAS float* prm = (const LAS float*)(lds + 90112);
    for (int it = bid * 8 + wid; it < 4096; it += nb * 8) {
        const int c = it & 63, h = (it >> 6) & 7, b = it >> 9;
        const bf16_t* vsrc = RW + ((size_t)b * SEQ + 64 * c - 1 + (lane >> 3)) * 1792 + 1024 + h * 64 + (lane & 7) * 8;
        bf16x8 sf[2][4];
        if (c > 0) { const bf16_t* S0 = (const bf16_t*)(a.ws + RS_MP) + (size_t)(it - 1) * 4096;
#pragma unroll
            for (int ks = 0; ks < 4; ++ks)
#pragma unroll
                for (int ia = 0; ia < 2; ++ia) sf[ia][ks] = *(const bf16x8*)(S0 + (32 * ia + r32) * 64 + 8 * hi + 16 * ks); }
#pragma unroll 1
        for (int tbr = 0; tbr < 2; ++tbr) { const int tb = 1 - tbr;
            f32x16 y[2], g[2];
            const int t = 64 * c + 32 * tb + r32; const size_t m = (size_t)b * SEQ + t;
            bf16x8 rf[4];
            if (c > 0) {
                const bf16_t* RH = (const bf16_t*)(a.ws + rs_rh_off(it)) + (32 * tb + r32) * 64 + 8 * hi;
#pragma unroll
                for (int ks = 0; ks < 4; ++ks) rf[ks] = *(const bf16x8*)(RH + 16 * ks);
            }
            u32x4 wv[5]; const int kb = tb ? 4 : 0;
#pragma unroll
            for (int j = 0; j < 5; ++j) { const int k = kb + j; wv[j] = (u32x4){0u, 0u, 0u, 0u}; if ((j < 4 || tb) && (c > 0 || k > 0 || (lane >> 3) > 0)) wv[j] = *(const u32x4*)(vsrc + (size_t)(8 * k) * 1792); }
            const float bon = ((const float*)(a.ws + RS_GCB))[(size_t)it * 128 + 64 + 32 * tb + r32];
            u32x4 yv[2][2];
#pragma unroll
            for (int ia = 0; ia < 2; ++ia) { const bf16_t* Y0 = (const bf16_t*)(a.ws + RS_Y0) + (size_t)it * 4096 + ((ia * 2 + tb) * 64 + lane) * 16; yv[ia][0] = *(const u32x4*)Y0; yv[ia][1] = *(const u32x4*)(Y0 + 8); }
            u32x4 pp[8], ss[8];
#pragma unroll
            for (int ks = 0; ks < 8; ++ks) { const int col = 1664 + 16 * ks + 8 * hi; pp[ks] = *(const u32x4*)(RW + m * 1792 + col); ss[ks] = (u32x4){0u, 0u, 0u, 0u}; if (t > 0) ss[ks] = *(const u32x4*)(RW + (m - 1) * 1792 + col); }
#pragma unroll
            for (int j = 0; j < 5; ++j) if (j < 4 || tb) *(LAS u32x4*)(vb + (8 * (kb + j) + (lane >> 3)) * PITCH + (lane & 7) * 16) = wv[j];
#pragma unroll
            for (int ia = 0; ia < 2; ++ia) { const u32x4 v0 = yv[ia][0], v1 = yv[ia][1]; const unsigned w[8] = {v0.x, v0.y, v0.z, v0.w, v1.x, v1.y, v1.z, v1.w};
#pragma unroll
                for (int e = 0; e < 8; ++e) { y[ia][2 * e] = bflo(w[e]); y[ia][2 * e + 1] = bfhi(w[e]); }
                g[ia] = zero16(); }
#pragma unroll
            for (int ks = 0; ks < 8; ++ks) {
                const f32x4 ma_ = *(const LAS f32x4*)(mgl + 16 * ks + 8 * hi), mb_ = *(const LAS f32x4*)(mgl + 16 * ks + 8 * hi + 4); const float mv[8] = {ma_.x, ma_.y, ma_.z, ma_.w, mb_.x, mb_.y, mb_.z, mb_.w};
                const u32x4 p = pp[ks], s = ss[ks];
                const unsigned pw[4] = {p.x, p.y, p.z, p.w}, sw[4] = {s.x, s.y, s.z, s.w}; float x[8];
#pragma unroll
                for (int e = 0; e < 4; ++e) { const float pl_ = bflo(pw[e]), ph_ = bfhi(pw[e]); x[2 * e] = fsigm(pl_ + (bflo(sw[e]) - pl_) * mv[2 * e]); x[2 * e + 1] = fsigm(ph_ + (bfhi(sw[e]) - ph_) * mv[2 * e + 1]); }
                const u32x4 xw = (u32x4){cvtpk(x[0], x[1]), cvtpk(x[2], x[3]), cvtpk(x[4], x[5]), cvtpk(x[6], x[7])}; const bf16x8 xf = __builtin_bit_cast(bf16x8, xw);
#pragma unroll
                for (int ia = 0; ia < 2; ++ia) g[ia] = __builtin_amdgcn_mfma_f32_32x32x16_bf16(*(const LAS bf16x8*)(g2l + (32 * ia + r32) * 272 + 32 * ks + 16 * hi), xf, g[ia], 0, 0, 0);
            }
            if (c > 0) {
#pragma unroll
                for (int ks = 0; ks < 4; ++ks)
#pragma unroll
                    for (int ia = 0; ia < 2; ++ia) y[ia] = __builtin_amdgcn_mfma_f32_32x32x16_bf16(sf[ia][ks], rf[ks], y[ia], 0, 0, 0);
            }
            float s = 0.f;
#pragma unroll
            for (int ia = 0; ia < 2; ++ia)
#pragma unroll
                for (int r = 0; r < 16; ++r) s += y[ia][r];
            s += __shfl_xor(s, 32); const float mean = s * (1.f / 64.f); float q = 0.f;
#pragma unroll
            for (int ia = 0; ia < 2; ++ia)
#pragma unroll
                for (int r = 0; r < 16; ++r) { y[ia][r] -= mean; q += y[ia][r] * y[ia][r]; }
            q += __shfl_xor(q, 32); const float rstd = rsqrtf(q * (1.f / 64.f) + GN_EPS);
            LAS unsigned char* rowc = vb + (32 * tb + r32 + 1) * PITCH;
            asm volatile("s_waitcnt lgkmcnt(0)" ::: "memory");
#pragma unroll
            for (int ia = 0; ia < 2; ++ia)
#pragma unroll
                for (int qp = 0; qp < 2; ++qp) {
                    u32x2 p[2], sp[2], w[2]; f32x4 mq_[2], lg_[2], lb_[2];
#pragma unroll
                    for (int u = 0; u < 2; ++u) { const int i0 = 32 * ia + 8 * (2 * qp + u) + 4 * hi;
                        p[u] = *(const LAS u32x2*)(rowc + i0 * 2); sp[u] = *(const LAS u32x2*)(rowc - PITCH + i0 * 2);
                        mq_[u] = *(const LAS f32x4*)(prm + i0); lg_[u] = *(const LAS f32x4*)(prm + 64 + i0); lb_[u] = *(const LAS f32x4*)(prm + 128 + i0); }
#pragma unroll
                    for (int u = 0; u < 2; ++u) { const int qd = 2 * qp + u;
                        const float pv[4] = {bflo(p[u].x), bfhi(p[u].x), bflo(p[u].y), bfhi(p[u].y)}, sv[4] = {bflo(sp[u].x), bfhi(sp[u].x), bflo(sp[u].y), bfhi(sp[u].y)};
                        float o[4];
#pragma unroll
                        for (int e = 0; e < 4; ++e) { const float v = pv[e] + (sv[e] - pv[e]) * mq_[u][e];
                            o[e] = (y[ia][4 * qd + e] * rstd * lg_[u][e] + lb_[u][e] + bon * v) * g[ia][4 * qd + e]; }
                        w[u].x = cvtpk(o[0], o[1]); w[u].y = cvtpk(o[2], o[3]); }
                    asm volatile("s_waitcnt lgkmcnt(0)" ::: "memory");
#pragma unroll
                    for (int u = 0; u < 2; ++u) *(LAS u32x2*)(rowc + (32 * ia + 8 * (2 * qp + u) + 4 * hi) * 2) = w[u]; }
        }
        asm volatile("s_waitcnt lgkmcnt(0)" ::: "memory");
        {
            bf16_t* odst = OB + ((size_t)b * SEQ + 64 * c + (lane >> 3)) * 512 + h * 64 + (lane & 7) * 8;
#pragma unroll
            for (int k = 0; k < 8; ++k) *(u32x4*)(odst + (size_t)(8 * k) * 512) = *(const LAS u32x4*)(vb + (8 * k + (lane >> 3) + 1) * PITCH + (lane & 7) * 16);
        }
        asm volatile("s_waitcnt lgkmcnt(0)" ::: "memory");
    }
}
__device__ __forceinline__ void phase_convfix(const Args& a, int bid, int nb) {
    const float* U4 = (const float*)(a.ws + WS_U4); bf16_t* ACT = (bf16_t*)(a.ws + WS_ACT);
    const float* cw = a.in[I_CW]; const float* cb = a.in[I_CB];
    const int total = 256 * 2816;
    for (int e0 = bid * 512 + threadIdx.x; e0 < total; e0 += 3 * nb * 512) {
        float u0[3][2], u1[3][2], pm2[3][2], pm1[3][2], w0[3][2], w1[3][2], w2[3][2], bb[3][2];
#pragma unroll
        for (int q = 0; q < 3; ++q) { const int e = e0 + q * nb * 512; const bool ok = e < total; const int ee = ok ? e : 0;
            const int blk = ee / 2816, c = ee % 2816, tc = (c >> 7) * 256 + (c & 127); const bool first = (blk & 31) == 0; const int pb = first ? blk : blk - 1;
#pragma unroll
            for (int bj = 0; bj < 2; ++bj) { const int oc = bj * 2816 + c, tcc = tc + bj * 128;
                u0[q][bj] = U4[((size_t)blk * 4 + 0) * 5632 + tcc]; u1[q][bj] = U4[((size_t)blk * 4 + 1) * 5632 + tcc];
                const float a2 = U4[((size_t)pb * 4 + 2) * 5632 + tcc], a1 = U4[((size_t)pb * 4 + 3) * 5632 + tcc]; pm2[q][bj] = first ? 0.f : a2; pm1[q][bj] = first ? 0.f : a1;
                w0[q][bj] = cw[oc]; w1[q][bj] = cw[5632 + oc]; w2[q][bj] = cw[2 * 5632 + oc]; bb[q][bj] = cb[oc]; } }
#pragma unroll
        for (int q = 0; q < 3; ++q) { const int e = e0 + q * nb * 512; if (e < total) { const int blk = e / 2816, c = e % 2816;
            float cc[2][2];
#pragma unroll
            for (int bj = 0; bj < 2; ++bj) { cc[0][bj] = bb[q][bj] + w0[q][bj] * pm2[q][bj] + w1[q][bj] * pm1[q][bj] + w2[q][bj] * u0[q][bj];
                cc[1][bj] = bb[q][bj] + w0[q][bj] * pm1[q][bj] + w1[q][bj] * u0[q][bj] + w2[q][bj] * u1[q][bj]; }
#pragma unroll
            for (int r = 0; r < 2; ++r) { const float gt = cc[r][1]; ACT[(((size_t)(blk >> 1) * 44 + (c >> 6)) * 256 + (blk & 1) * 128 + r) * 64 + (c & 63)] = (bf16_t)f2bf(gt * sigmoidf_(gt) * cc[r][0]); } } }
    }
}

typedef GAS unsigned gu32;
#define RLX_AGENT __ATOMIC_RELAXED, __HIP_MEMORY_SCOPE_AGENT
#define XB_TMO      128
#define XB_XCNT(j)  (256  + 64 * (j))
#define XB_XSUB(j)  (1280 + 64 * (j))
#define XB_XGEN(j)  (2304 + 64 * (j))
#define XB_TOP      3328
#define XB_TOPGEN   3392
#define XCD_BAR_WORDS 3456
#define XB_SPIN_CAP (1u << 18)

__device__ __forceinline__ unsigned xb_ld(unsigned* p)              { return __hip_atomic_load(p, __ATOMIC_RELAXED, __HIP_MEMORY_SCOPE_AGENT); }
__device__ __forceinline__ unsigned xb_add(unsigned* p, unsigned v) { return __hip_atomic_fetch_add(p, v, __ATOMIC_RELAXED, __HIP_MEMORY_SCOPE_AGENT); }
__device__ __forceinline__ unsigned xb_xcc_id() { return (unsigned)__builtin_amdgcn_s_getreg((3 << 11) | 20) & 0xFu; }
#define XB_SPIN(cond, bar) do { unsigned _sp = 0; while (cond) { __builtin_amdgcn_s_sleep(1); \
    if ((++_sp & 255u) == 0u) { if (xb_ld(&(bar)[XB_TMO])) break; if (_sp > XB_SPIN_CAP) { atomicAdd(&(bar)[XB_TMO], 1u); break; } } } } while (0)

struct XcdBarrier {
    unsigned* bar; unsigned x;
    volatile LAS unsigned* st;
};

__device__ __forceinline__ XcdBarrier xcd_barrier_post(unsigned* bar, volatile LAS unsigned* st) {
    XcdBarrier b; b.bar = bar; b.x = xb_xcc_id(); b.st = st;
    if (threadIdx.x == 0) (void)xb_add(&bar[XB_XCNT(b.x)], 1u);
    return b;
}
__device__ __forceinline__ void xcd_barrier_complete(unsigned* bar, unsigned x, unsigned& nloc, unsigned& nx) {
    const unsigned G = gridDim.x * gridDim.y * gridDim.z;
    unsigned sum, cnt, mine, sp = 0u;
    for (;;) {
        sum = 0u; cnt = 0u; mine = 0u;
#pragma unroll
        for (unsigned j = 0; j < 16; ++j) { const unsigned c = xb_ld(&bar[XB_XCNT(j)]); sum += c; cnt += (c > 0u) ? 1u : 0u; mine = (j == x) ? c : mine; }
        if (sum == G) break;
        __builtin_amdgcn_s_sleep(1);
        if ((++sp & 255u) == 0u) { if (xb_ld(&bar[XB_TMO])) break; if (sp > XB_SPIN_CAP) { atomicAdd(&bar[XB_TMO], 1u); break; } }
    }
    nloc = mine > 0u ? mine : 1u; nx = cnt > 0u ? cnt : 1u;
}

__device__ __forceinline__ void xcd_barrier(const XcdBarrier& b) {
    asm volatile("s_waitcnt vmcnt(0)" ::: "memory");
    __syncthreads();
    if (threadIdx.x == 0) {
        unsigned* bar = b.bar;
        __builtin_amdgcn_s_waitcnt(0);
        unsigned nloc = b.st[0], nx = b.st[1];
        if (nloc == 0u) { xcd_barrier_complete(bar, b.x, nloc, nx); b.st[0] = nloc; b.st[1] = nx; }
        const unsigned old = xb_add(&bar[XB_XSUB(b.x)], 1u);
        const unsigned gen = old / nloc;
        if (old + 1u == (gen + 1u) * nloc) {
            __builtin_amdgcn_fence(__ATOMIC_RELEASE, "agent");
            asm volatile("s_waitcnt vmcnt(0)" ::: "memory");
            const unsigned og = xb_add(&bar[XB_TOP], 1u);
            const unsigned tg = og / nx;
            if (og + 1u == (tg + 1u) * nx) xb_add(&bar[XB_TOPGEN], 1u);
            else XB_SPIN(xb_ld(&bar[XB_TOPGEN]) == tg, bar);
            __builtin_amdgcn_fence(__ATOMIC_ACQUIRE, "agent");
            xb_add(&bar[XB_XGEN(b.x)], 1u);
            asm volatile("s_waitcnt vmcnt(0)" ::: "memory");
        } else {
            XB_SPIN(xb_ld(&bar[XB_XGEN(b.x)]) == gen, bar);
            __builtin_amdgcn_fence(__ATOMIC_ACQUIRE, "agent");
            asm volatile("s_waitcnt vmcnt(0)" ::: "memory");
        }
    }
    __syncthreads();
}

constexpr int N_PHASES = 17;
__global__ void __launch_bounds__(512, 2) mega(Args args) {
    extern __shared__ __attribute__((aligned(16))) unsigned char lds_raw[];
    LAS unsigned char* lds = (LAS unsigned char*)lds_raw;
    const int bid = blockIdx.x, nb = gridDim.x;
    unsigned char* ws = args.ws;
    volatile LAS unsigned* MISC = (volatile LAS unsigned*)(lds + 147456);
    if (threadIdx.x < 16) MISC[threadIdx.x] = 0u;
    __syncthreads();
    XcdBarrier xbar = xcd_barrier_post((unsigned*)(ws + WS_CTL) + 4096, MISC + 8);
#define GRID_SYNC() xcd_barrier(xbar)
#ifndef ONLY_PHASE
#define ONLY_PHASE -1
#endif
#define IN(k) ((ONLY_PHASE < 0 || ONLY_PHASE == (k)) && args.ph_lo <= (k) && (k) < args.ph_hi)
#ifndef REP_PHASE
#define REP_PHASE -1
#endif
#ifndef REP_N
#define REP_N 2
#endif
#define SEAM(k) do { if (args.ph_lo <= (k) && (k) + 1 < args.ph_hi) GRID_SYNC(); } while (0)
#define PHASE(k, ...) do { if (IN(k)) { for (int rep_ = 0; rep_ < (REP_PHASE == (k) ? REP_N : 1); ++rep_) { if (rep_) GRID_SYNC(); __VA_ARGS__ } } } while (0)
    PHASE(0, phase_prologue(args, lds, bid, nb);); SEAM(0);
    PHASE(1, { pg8::Gemm g{(const bf16_t*)(ws + WS_H), (const bf16_t*)(ws + WS_WIN), NT, NPROJ, 1024}; pg8::StaticOrder S; S.init(NT, NPROJ, nb, bid);
        { LAS f32x4* pl = (LAS f32x4*)(lds + 131072); const int t = threadIdx.x; pl[t] = ((const f32x4*)args.in[I_PEK])[t]; pl[512 + t] = ((const f32x4*)args.in[I_PEV])[t]; __syncthreads(); }
        pg8::EpiProj E{ws, args.in[I_QNG], args.in[I_KNG], (const LAS float*)(lds + 131072)};
        pg8::gemm_phase<pg8::EpiProj, pg8::StaticOrder, PG8_ALIGN, PG8_SP2>(lds, g, S, E); });
      SEAM(2);
    PHASE(3, {
        if (bid < 64) {
            const int tile = bid & 31, kh = bid >> 5, isv = tile >> 4;
            pg8::Gemm g{(const bf16_t*)(ws + (isv ? WS_FV : WS_FK)) + 1024 * kh, (const bf16_t*)(ws + (isv ? WS_WC1V : WS_WC1K)) + 1024 * kh, CMPROWS, 256, 1024, 2048};
            pg8::StaticOrder S; S.init(CMPROWS, 256, nb, tile & 15);
            if (kh) { pg8::EpiPartial E{ws, isv}; pg8::gemm_phase<pg8::EpiPartial, pg8::StaticOrder, false, PG8_SP2>(lds, g, S, E); }
            else { pg8::EpiCompress E{(const bf16_t*)(ws + WS_WC2T + (isv ? 32768 : 0)), (bf16_t*)(ws + (isv ? WS_VCB : WS_KCB)), isv ? nullptr : args.in[I_KNG], ws};
                   pg8::gemm_phase<pg8::EpiCompress, pg8::StaticOrder, false, PG8_SP2>(lds, g, S, E); } }
        else { if (bid == 64) { const int it = threadIdx.x >> 6, ln = threadIdx.x & 63;
                for (int k = 0; k < 4; ++k) { const int q = it * 4 + k; ((bf16_t*)(ws + ((q & 1) ? WS_VCB : WS_KCB)))[((size_t)(q >> 1) * 256 + 255) * 64 + ln] = 0; } }
            gates_items(args, (bid - 64) * 8 + (threadIdx.x >> 6), (nb - 64) * 8, threadIdx.x & 63); }
    });   SEAM(5);
    PHASE(6, phase_attn(args, lds, bid, nb););   { asm volatile("s_waitcnt vmcnt(0) lgkmcnt(0)" ::: "memory"); __syncthreads(); }
    PHASE(7, rwkv_pass1(args, lds, bid, nb);); SEAM(7);
    PHASE(8, { if (bid < 64) rwkv_pass2(args, lds, bid, nb); else if (nb > 64) prologue_late_items(args, (LAS float*)(lds + (threadIdx.x >> 6) * 16384), (bid - 64) * 8 + (threadIdx.x >> 6), (nb - 64) * 8, threadIdx.x & 63); else {} if (nb <= 64) prologue_late_items(args, (LAS float*)(lds + (threadIdx.x >> 6) * 16384), bid * 8 + (threadIdx.x >> 6), nb * 8, threadIdx.x & 63); }); SEAM(8);
    PHASE(9, rwkv_pass3(args, lds, bid, nb);); SEAM(9);
    for (int rep8_ = 0; rep8_ < (REP_PHASE == 10 ? REP_N : 1); ++rep8_) {
    if (rep8_) GRID_SYNC();
    PHASE(10, { pg8::Gemm g{(const bf16_t*)(ws + WS_OA), (const bf16_t*)(ws + WS_WPA), NT, 1024, 512}; pg8::StaticOrder S; S.init(NT, 1024, nb, bid);
        pg8::EpiMerge<0> E{(const unsigned char*)(ws + WS_GA), (bf16_t*)(ws + WS_MRG)}; pg8::gemm_phase<pg8::EpiMerge<0>, pg8::StaticOrder, PG8_ALIGN, PG8_SP2>(lds, g, S, E); });
    PHASE(11, { pg8::Gemm g{(const bf16_t*)(ws + WS_OB), (const bf16_t*)(ws + WS_WPB), NT, 1024, 512}; pg8::StaticOrder S; S.init(NT, 1024, nb, bid);
        pg8::EpiMerge<1> E{(const unsigned char*)(ws + WS_GB), (bf16_t*)(ws + WS_MRG)}; pg8::gemm_phase<pg8::EpiMerge<1>, pg8::StaticOrder, PG8_ALIGN, PG8_SP2>(lds, g, S, E); });
    }
    SEAM(11);
    PHASE(12, { pg8::Gemm g{(const bf16_t*)(ws + WS_MRG), (const bf16_t*)(ws + WS_WOUT), NT, 1024, 1024}; pg8::StaticOrder S; S.init(NT, 1024, nb, bid);
        pg8::EpiResidNorm E{args.in[I_X], args.out, (bf16_t*)(ws + WS_H), (float*)(ws + WS_PS)}; pg8::gemm_phase<pg8::EpiResidNorm, pg8::StaticOrder, PG8_ALIGN, PG8_SP2>(lds, g, S, E); }); SEAM(12);
    PHASE(14, { pg8::Gemm g{(const bf16_t*)(ws + WS_H), (const bf16_t*)(ws + WS_WUP), NT, DFF2, 1024, 0, 1}; pg8::NormOrder S; S.init(NT, DFF2, nb, bid); S.PS = (const float*)(ws + WS_PS); S.tab = (LAS float*)(lds + 131072); S.last = 0; S.tag0 = -1; S.tag1 = -1;
        if (threadIdx.x < 2) ((LAS int*)(lds + 131072 + 2048))[threadIdx.x] = -1;
        __syncthreads();
        pg8::EpiUpConv E{(bf16_t*)(ws + WS_ACT), (float*)(ws + WS_U4), args.in[I_CW], args.in[I_CB], (const float*)(ws + WS_PS), lds + 131072}; pg8::gemm_phase<pg8::EpiUpConv, pg8::NormOrder, PG8_ALIGN, PG8_SP2>(lds, g, S, E); }); SEAM(14);
    PHASE(15, phase_convfix(args, bid, nb);); SEAM(15);
    PHASE(16, { pg8::Gemm g{(const bf16_t*)(ws + WS_ACT), (const bf16_t*)(ws + WS_WDN), NT, 1024, DFF, 0, 1, 1}; pg8::StaticOrder S; S.init(NT, 1024, nb, bid);
        pg8::EpiResidB E{(const bf16_t*)(ws + WS_H), args.out}; pg8::gemm_phase<pg8::EpiResidB, pg8::StaticOrder, PG8_ALIGN, PG8_SP2>(lds, g, S, E); });
#undef PHASE
#undef IN
#undef SEAM
}

extern "C" void kernel_launch(void* const* d_in, const int* in_sizes, int n_in, void* d_out, int out_size, void* d_ws, size_t ws_size, hipStream_t stream) {
    static int grid = 0;
    if (grid == 0) {
        if (n_in != 31 || out_size != NT * DM || ws_size < 511 * MiB) { fprintf(stderr, "kernel_launch: unexpected problem (n_in %d out %d ws %zu); nothing launched\n", n_in, out_size, ws_size); grid = -1; return; }
        int dev = 0, cus = 0, per_cu = 0;
        (void)hipGetDevice(&dev); (void)hipDeviceGetAttribute(&cus, hipDeviceAttributeMultiprocessorCount, dev);
        if (hipFuncSetAttribute((const void*)mega, hipFuncAttributeMaxDynamicSharedMemorySize, LDS_BYTES) != hipSuccess) { fprintf(stderr, "kernel_launch: hipFuncSetAttribute failed\n"); grid = -1; return; }
        (void)hipOccupancyMaxActiveBlocksPerMultiprocessor(&per_cu, (const void*)mega, 512, LDS_BYTES);
        (void)hipGetLastError();
        if (per_cu < 1) per_cu = 1;
        grid = cus >= 64 ? cus / 64 * 64 : cus;
        if (grid % 64) { fprintf(stderr, "kernel_launch: unsupported CU count %d\n", cus); grid = -1; return; }
        fprintf(stderr, "kernel_launch: cus %d occupancy/cu %d grid %d\n", cus, per_cu, grid);
    }
    if (grid < 0) return;
    Args a{};
    for (int i = 0; i < 31; ++i) a.in[i] = (const float*)d_in[i];
    a.out = (float*)d_out; a.ws = (unsigned char*)d_ws;
    a.ph_lo = 0; a.ph_hi = N_PHASES;
    if (hipMemsetAsync((char*)d_ws + WS_CTL, 0, 65536, stream) != hipSuccess) { fprintf(stderr, "kernel_launch: memset of the barrier words failed\n"); return; }
    hipLaunchKernelGGL(mega, dim3(grid), dim3(512), LDS_BYTES, stream, a);
}
```
